# Optimizing an MI355X kernel written in HIP

```python
import math
import jax, jax.numpy as jnp
from jax import lax
import numpy as np

D_MODEL = 1024
BATCH = 4
SEQ = 4096
DEPTH = 2
DEC_BATCH = 1
DEC_SEQ = 16384
PAST_LEN = 128

A_WIDTH = D_MODEL // 2
B_WIDTH = D_MODEL - A_WIDTH
A_HEAD_DIM = 64
A_V_DIM = 2 * A_HEAD_DIM
A_HEADS = A_WIDTH // A_V_DIM
B_V_DIM = 128
B_HEADS = B_WIDTH // B_V_DIM
B_NOPE = 128
B_ROPE = 64
B_QK_DIM = B_NOPE + B_ROPE
Q_LORA = D_MODEL // 4
KV_LORA = D_MODEL // 8
ROPE_THETA = 10000.0
Q_BLOCK = 128
EPS = 1e-6

A_Q_COLS = A_HEADS * 2 * A_HEAD_DIM
A_K_COLS = A_HEADS * 2 * A_HEAD_DIM
A_V_COLS = A_HEADS * A_V_DIM
A_G_COLS = A_WIDTH
B_CQ_COLS = Q_LORA
B_CKV_COLS = KV_LORA
B_KR_COLS = B_ROPE
B_G_COLS = B_WIDTH
COL_SIZES = [A_Q_COLS, A_K_COLS, A_V_COLS, A_G_COLS, B_CQ_COLS, B_CKV_COLS, B_KR_COLS, B_G_COLS]
IN_COLS = sum(COL_SIZES)
SPLIT_POINTS = [int(v) for v in np.cumsum(COL_SIZES)[:-1]]

kernel_name = "hymba_diffattn_mla_encoder"


def rms_norm(x, g):
    xf = x.astype(jnp.float32)
    y = xf * lax.rsqrt(jnp.mean(xf * xf, axis=-1, keepdims=True) + EPS)
    return (y * g.astype(jnp.float32)).astype(x.dtype)


def alibi_slopes(n):
    return jnp.exp2(-8.0 * jnp.arange(1, n + 1, dtype=jnp.float32) / n)


def lambda_init_value(layer_idx):
    return 0.8 - 0.6 * math.exp(-0.3 * layer_idx)


def apply_rope(x):
    s = x.shape[1]
    half = B_ROPE // 2
    inv = ROPE_THETA ** (-jnp.arange(0, B_ROPE, 2, dtype=jnp.float32) / B_ROPE)
    ang = jnp.arange(s, dtype=jnp.float32)[:, None] * inv[None, :]
    cos = jnp.cos(ang)[None, :, None, :]
    sin = jnp.sin(ang)[None, :, None, :]
    xf = x.astype(jnp.float32)
    x1, x2 = xf[..., :half], xf[..., half:]
    return jnp.concatenate([x1 * cos - x2 * sin, x1 * sin + x2 * cos], axis=-1).astype(x.dtype)


def diff_attention(q, k, v, lam):
    b, s, h = q.shape[:3]
    nb = s // Q_BLOCK
    qb = q.reshape(b, nb, Q_BLOCK, h, 2, A_HEAD_DIM).transpose(1, 0, 2, 3, 4, 5)
    starts = jnp.arange(nb, dtype=jnp.int32) * Q_BLOCK
    slopes = alibi_slopes(h)
    kpos = jnp.arange(s, dtype=jnp.int32)

    def block(args):
        qi, s0 = args
        qpos = s0 + jnp.arange(Q_BLOCK, dtype=jnp.int32)
        dist = jnp.abs(qpos[:, None] - kpos[None, :]).astype(jnp.float32)
        bias = -slopes[:, None, None, None] * dist[None, None]
        sc = jnp.einsum('bqhcd,bkhcd->bhcqk', qi, k).astype(jnp.float32) + bias
        p = jax.nn.softmax(sc, axis=-1)
        p = p[:, :, 0] - lam * p[:, :, 1]
        return jnp.einsum('bhqk,bkhd->bqhd', p.astype(v.dtype), v)

    o = lax.map(block, (qb, starts))
    return o.transpose(1, 0, 2, 3, 4).reshape(b, s, h, A_V_DIM)


def latent_attention(q, k, v):
    b, s, h = q.shape[:3]
    nb = s // Q_BLOCK
    qb = q.reshape(b, nb, Q_BLOCK, h, B_QK_DIM).transpose(1, 0, 2, 3, 4)

    def block(qi):
        sc = jnp.einsum('bqhd,bkhd->bhqk', qi, k).astype(jnp.float32)
        p = jax.nn.softmax(sc, axis=-1)
        return jnp.einsum('bhqk,bkhd->bqhd', p.astype(v.dtype), v)

    o = lax.map(block, qb)
    return o.transpose(1, 0, 2, 3, 4).reshape(b, s, h, B_V_DIM)


def encoder_layer(x, layer_idx, norm_w, w_in, a_q_norm, a_k_norm, a_lq1, a_lk1, a_lq2, a_lk2,
                  a_subln, b_cq_norm, b_w_uq, b_ckv_norm, b_w_ukv, b_q_norm, b_k_norm, w_out):
    b, s, _ = x.shape
    h = rms_norm(x, norm_w)
    proj = h @ w_in
    aq, ak, av, ag, cq, ckv, kr, bg = jnp.split(proj, SPLIT_POINTS, axis=-1)

    aq = rms_norm(aq.reshape(b, s, A_HEADS, 2, A_HEAD_DIM), a_q_norm) * (A_HEAD_DIM ** -0.5)
    ak = rms_norm(ak.reshape(b, s, A_HEADS, 2, A_HEAD_DIM), a_k_norm)
    av = av.reshape(b, s, A_HEADS, A_V_DIM)
    lam_init = lambda_init_value(layer_idx)
    lam = (jnp.exp(jnp.sum(a_lq1.astype(jnp.float32) * a_lk1.astype(jnp.float32)))
           - jnp.exp(jnp.sum(a_lq2.astype(jnp.float32) * a_lk2.astype(jnp.float32)))
           + lam_init)
    oa = diff_attention(aq, ak, av, lam)
    oa = rms_norm(oa, a_subln) * (1.0 - lam_init)
    ya = oa.reshape(b, s, A_WIDTH) * jax.nn.silu(ag)

    cq = rms_norm(cq, b_cq_norm)
    q = (cq @ b_w_uq).reshape(b, s, B_HEADS, B_QK_DIM)
    ckv = rms_norm(ckv, b_ckv_norm)
    kv = (ckv @ b_w_ukv).reshape(b, s, B_HEADS, B_NOPE + B_V_DIM)
    k_nope, bv = kv[..., :B_NOPE], kv[..., B_NOPE:]
    k_rope = jnp.broadcast_to(kr[:, :, None, :], (b, s, B_HEADS, B_ROPE))
    k = jnp.concatenate([k_nope, k_rope], axis=-1)
    q = rms_norm(q, b_q_norm)
    k = rms_norm(k, b_k_norm)
    q = jnp.concatenate([q[..., :B_NOPE], apply_rope(q[..., B_NOPE:])], axis=-1) * (B_QK_DIM ** -0.5)
    k = jnp.concatenate([k[..., :B_NOPE], apply_rope(k[..., B_NOPE:])], axis=-1)
    ob = latent_attention(q, k, bv)
    yb = ob.reshape(b, s, B_WIDTH) * jax.nn.silu(bg)

    out = jnp.concatenate([ya, yb], axis=-1) @ w_out
    return x + out


def setup_inputs(seed: int = 0) -> dict:
    key = jax.random.key(seed)
    ks = jax.random.split(key, 20)
    f32 = jnp.float32

    def nrm(k, shape, scale):
        return jax.random.normal(k, shape, f32) * scale

    def gain(k, shape):
        return 1.0 + 0.1 * jax.random.normal(k, shape, f32)

    return {
        "x_prompt": jax.random.normal(ks[0], (BATCH, SEQ, D_MODEL), f32),
        "x_sample": jax.random.normal(ks[1], (DEC_BATCH, DEC_SEQ, D_MODEL), f32),
        "norm_w": gain(ks[2], (DEPTH, D_MODEL)),
        "w_in": nrm(ks[3], (DEPTH, D_MODEL, IN_COLS), D_MODEL ** -0.5),
        "a_q_norm": gain(ks[4], (DEPTH, A_HEAD_DIM)),
        "a_k_norm": gain(ks[5], (DEPTH, A_HEAD_DIM)),
        "a_lq1": nrm(ks[6], (DEPTH, A_HEAD_DIM), 0.1),
        "a_lk1": nrm(ks[7], (DEPTH, A_HEAD_DIM), 0.1),
        "a_lq2": nrm(ks[8], (DEPTH, A_HEAD_DIM), 0.1),
        "a_lk2": nrm(ks[9], (DEPTH, A_HEAD_DIM), 0.1),
        "a_subln": gain(ks[10], (DEPTH, A_V_DIM)),
        "b_cq_norm": gain(ks[11], (DEPTH, Q_LORA)),
        "b_w_uq": nrm(ks[12], (DEPTH, Q_LORA, B_HEADS * B_QK_DIM), Q_LORA ** -0.5),
        "b_ckv_norm": gain(ks[13], (DEPTH, KV_LORA)),
        "b_w_ukv": nrm(ks[14], (DEPTH, KV_LORA, B_HEADS * (B_NOPE + B_V_DIM)), KV_LORA ** -0.5),
        "b_q_norm": gain(ks[15], (DEPTH, B_QK_DIM)),
        "b_k_norm": gain(ks[16], (DEPTH, B_QK_DIM)),
        "w_out": nrm(ks[17], (DEPTH, D_MODEL, D_MODEL), D_MODEL ** -0.5),
    }


def reference(x_prompt, x_sample, norm_w, w_in, a_q_norm, a_k_norm, a_lq1, a_lk1, a_lq2, a_lk2,
              a_subln, b_cq_norm, b_w_uq, b_ckv_norm, b_w_ukv, b_q_norm, b_k_norm, w_out):
    y_prompt = x_prompt
    y_sample = x_sample
    for l in range(DEPTH):
        p = (norm_w[l], w_in[l], a_q_norm[l], a_k_norm[l], a_lq1[l], a_lk1[l], a_lq2[l], a_lk2[l],
             a_subln[l], b_cq_norm[l], b_w_uq[l], b_ckv_norm[l], b_w_ukv[l], b_q_norm[l], b_k_norm[l], w_out[l])
        y_prompt = encoder_layer(y_prompt, l, *p)
        y_sample = encoder_layer(y_sample, l, *p)
    return (y_prompt, y_sample)
```

```cpp
#include <hip/hip_runtime.h>
#include <hip/hip_cooperative_groups.h>
#include <cstdio>
#include <cstdint>
namespace cg = cooperative_groups;

typedef unsigned short u16;
using bf16x8 = __attribute__((ext_vector_type(8))) short;
using s16x4  = __attribute__((ext_vector_type(4))) short;
using f32x16 = __attribute__((ext_vector_type(16))) float;
using f32x4  = __attribute__((ext_vector_type(4))) float;
using u32x4  = __attribute__((ext_vector_type(4))) unsigned;
using u32x2  = __attribute__((ext_vector_type(2))) unsigned;
#define DEV __device__ __forceinline__
#define SBAR() __builtin_amdgcn_sched_barrier(0)

constexpr int TB = 16384, DM = 1024, NPAD = 3072, INC = 3008, NTHR = 512;
constexpr float EPS = 1e-6f, LOG2E = 1.4426950408889634f;
constexpr int LDS_BYTES = 139264;
constexpr int LDS_WS = 131072;

struct Params {
  const float* xin0; const float* xin1;
  const float* norm_w; const float* w_in; const float* a_q_norm; const float* a_k_norm;
  const float* a_lq1; const float* a_lk1; const float* a_lq2; const float* a_lk2;
  const float* a_subln; const float* b_cq_norm; const float* b_w_uq; const float* b_ckv_norm;
  const float* b_w_ukv; const float* b_q_norm; const float* b_k_norm; const float* w_out;
  float* out;
  char* ws;
};
constexpr size_t al256(size_t x) { return (x + 255) & ~(size_t)255; }
constexpr size_t O_XB = 0;
constexpr size_t O_QA = O_XB + al256((size_t)2 * TB * DM * 2);
constexpr size_t O_KA = O_QA + al256((size_t)TB * 512 * 2);
constexpr size_t O_VA = O_KA + al256((size_t)TB * 512 * 2);
constexpr size_t O_G = O_VA + al256((size_t)TB * 512 * 2);
constexpr size_t O_CQ = O_G + al256((size_t)TB * 1024 * 2);
constexpr size_t O_CKV = O_CQ + al256((size_t)TB * 256 * 2);
constexpr size_t O_KR = O_CKV + al256((size_t)TB * 128 * 2);
constexpr size_t O_QB = O_KR + al256((size_t)TB * 64 * 4);
constexpr size_t O_KB = O_QB + al256((size_t)TB * 768 * 2);
constexpr size_t O_VB = O_KB + al256((size_t)TB * 768 * 2);
constexpr size_t O_SSQX = O_VB + al256((size_t)TB * 512 * 2);
constexpr size_t O_SSQCQ = O_SSQX + al256((size_t)2 * 16 * TB * 4);
constexpr size_t O_SSQCKV = O_SSQCQ + al256((size_t)4 * TB * 4);
constexpr size_t O_WIN = O_SSQCKV + al256((size_t)2 * TB * 4);
constexpr size_t O_WOUT = O_WIN + al256((size_t)2 * NPAD * DM * 2);
constexpr size_t O_WUQ = O_WOUT + al256((size_t)2 * 1024 * DM * 2);
constexpr size_t O_WUKV = O_WUQ + al256((size_t)2 * 768 * 256 * 2);
constexpr size_t O_ROPE = O_WUKV + al256((size_t)2 * 1024 * 128 * 2);
constexpr size_t O_CONST = O_ROPE + al256((size_t)16384 * 32 * 8);
constexpr size_t WS_END = O_CONST + 8192;
struct WS {
  char* b;
  DEV u16* XB() const { return (u16*)(b + O_XB); }   DEV u16* QA() const { return (u16*)(b + O_QA); }
  DEV u16* KA() const { return (u16*)(b + O_KA); }   DEV u16* VA() const { return (u16*)(b + O_VA); }
  DEV u16* G() const { return (u16*)(b + O_G); }     DEV u16* CQ() const { return (u16*)(b + O_CQ); }
  DEV u16* CKV() const { return (u16*)(b + O_CKV); } DEV float* KR() const { return (float*)(b + O_KR); }
  DEV u16* QB() const { return (u16*)(b + O_QB); }   DEV u16* KB() const { return (u16*)(b + O_KB); }
  DEV u16* VB() const { return (u16*)(b + O_VB); }
  DEV float* ssq_x() const { return (float*)(b + O_SSQX); } DEV float* ssq_cq() const { return (float*)(b + O_SSQCQ); }
  DEV float* ssq_ckv() const { return (float*)(b + O_SSQCKV); }
  DEV u16* WinT() const { return (u16*)(b + O_WIN); } DEV u16* WoutT() const { return (u16*)(b + O_WOUT); }
  DEV u16* WuqT() const { return (u16*)(b + O_WUQ); } DEV u16* WukvT() const { return (u16*)(b + O_WUKV); }
  DEV float2* rope() const { return (float2*)(b + O_ROPE); } DEV float* consts() const { return (float*)(b + O_CONST); }
};

DEV int opaque_tid() { int t = threadIdx.x; asm volatile("" : "+v"(t)); return t; }
DEV int opaque_bid() { int b = blockIdx.x; asm volatile("" : "+s"(b)); return b; }
DEV int opaque_nb() { int b = gridDim.x; asm volatile("" : "+s"(b)); return b; }
DEV int crow(int r, int hi) { return (r & 3) + 8 * (r >> 2) + 4 * hi; }
DEV unsigned cvtpk(float lo, float hi) {
  unsigned r; asm volatile("v_cvt_pk_bf16_f32 %0, %1, %2" : "=v"(r) : "v"(lo), "v"(hi)); return r;
}
DEV float swapsum(float v) {
  auto rr = __builtin_amdgcn_permlane32_swap(__float_as_uint(v), __float_as_uint(v), false, false);
  return __uint_as_float(rr[0]) + __uint_as_float(rr[1]);
}
#define SWZ_XOR(v, k) __int_as_float(__builtin_amdgcn_ds_swizzle(__float_as_int(v), ((k) << 10) | 0x1F))
DEV float siluf(float x) { return x * __builtin_amdgcn_rcpf(1.f + __builtin_amdgcn_exp2f(-LOG2E * x)); }
DEV float bf2f(u16 v) { return __uint_as_float(((unsigned)v) << 16); }

DEV void store8bf(u16* dst, const float* v) {
  u32x4 w = {cvtpk(v[0], v[1]), cvtpk(v[2], v[3]), cvtpk(v[4], v[5]), cvtpk(v[6], v[7])};
  *reinterpret_cast<u32x4*>(dst) = w;
}

DEV void cvt_transpose_tiles(const float* __restrict__ src, const float* __restrict__ scale, u16* __restrict__ dst, int L, int Kd, int Nsrc, int Ndst, int padlo, int padhi, char* lds, int tid) {
  const int kt = Kd >> 6, ntl = Ndst >> 6, total = L * kt * ntl;
  u16* T = reinterpret_cast<u16*>(lds);
  const int kk = tid >> 3, n8 = (tid & 7) * 8;
  for (int tile = blockIdx.x; tile < total; tile += gridDim.x) {
    const int l = tile / (kt * ntl), r = tile - l * (kt * ntl), kb = r / ntl, nb = r - kb * ntl;
    const int n0 = nb * 64, k0 = kb * 64;
    const int col0 = n0 < padlo ? n0 : (n0 < padhi ? -1 : n0 - (padhi - padlo));
    float v[8];
    if (col0 >= 0) {
      const float* s = src + ((long)l * Kd + k0 + kk) * Nsrc + col0 + n8;
      const float4 a = *reinterpret_cast<const float4*>(s), b = *reinterpret_cast<const float4*>(s + 4);
      const float sc = scale ? scale[l * Kd + k0 + kk] : 1.f;
      v[0] = a.x * sc; v[1] = a.y * sc; v[2] = a.z * sc; v[3] = a.w * sc; v[4] = b.x * sc; v[5] = b.y * sc; v[6] = b.z * sc; v[7] = b.w * sc;
    } else {
#pragma unroll
      for (int j = 0; j < 8; ++j) v[j] = 0.f;
    }
#pragma unroll
    for (int j = 0; j < 8; j += 2) { const unsigned w = cvtpk(v[j], v[j + 1]); T[(n8 + j) * 72 + kk] = (u16)(w & 0xffffu); T[(n8 + j + 1) * 72 + kk] = (u16)(w >> 16); }
    __syncthreads();
    {
      const int nn = tid >> 3, k8 = (tid & 7) * 8;
      const u32x4 o = *reinterpret_cast<const u32x4*>(T + nn * 72 + k8);
      *reinterpret_cast<u32x4*>(dst + ((long)l * Ndst + n0 + nn) * Kd + k0 + k8) = o;
    }
    __syncthreads();
  }
}

DEV void phase_prologue(const Params& P, char* lds) {
  const int tid = opaque_tid(), lane = tid & 63, wid = tid >> 6;
  const int gw = blockIdx.x * 8 + wid, nw = gridDim.x * 8;
  for (int row0 = gw * 4; row0 < 2 * TB; row0 += nw * 4) {
    float4 v[4][4];
#pragma unroll
    for (int q = 0; q < 4; ++q) {
      const int row = row0 + q, b = row >> 14, t = row & (TB - 1);
      const float* x = (b ? P.xin1 : P.xin0) + (long)t * DM;
#pragma unroll
      for (int i = 0; i < 4; ++i) v[q][i] = *reinterpret_cast<const float4*>(x + i * 256 + lane * 4);
    }
#pragma unroll
    for (int q = 0; q < 4; ++q) {
      const int row = row0 + q, b = row >> 14, t = row & (TB - 1);
      u16* xb = WS{P.ws}.XB() + (long)row * DM;
      float ss = 0.f;
#pragma unroll
      for (int i = 0; i < 4; ++i) {
        ss += v[q][i].x * v[q][i].x + v[q][i].y * v[q][i].y + v[q][i].z * v[q][i].z + v[q][i].w * v[q][i].w;
        u32x2 o = {cvtpk(v[q][i].x, v[q][i].y), cvtpk(v[q][i].z, v[q][i].w)};
        *reinterpret_cast<u32x2*>(xb + i * 256 + lane * 4) = o;
      }
      ss += SWZ_XOR(ss, 1); ss += SWZ_XOR(ss, 2); ss += SWZ_XOR(ss, 4); ss += SWZ_XOR(ss, 8); ss += SWZ_XOR(ss, 16); ss = swapsum(ss);
      if (lane < 16) WS{P.ws}.ssq_x()[((long)b * 16 + lane) * TB + t] = (lane == 0) ? ss : 0.f;
    }
  }
  const long gt = (long)blockIdx.x * NTHR + tid, nth = (long)gridDim.x * NTHR;
  cvt_transpose_tiles(P.w_in, P.norm_w, WS{P.ws}.WinT(), 2, 1024, INC, NPAD, 2496, 2560, lds, tid);
  cvt_transpose_tiles(P.w_out, nullptr, WS{P.ws}.WoutT(), 2, 1024, 1024, 1024, 1 << 30, 1 << 30, lds, tid);
  cvt_transpose_tiles(P.b_w_uq, P.b_cq_norm, WS{P.ws}.WuqT(), 2, 256, 768, 768, 1 << 30, 1 << 30, lds, tid);
  cvt_transpose_tiles(P.b_w_ukv, P.b_ckv_norm, WS{P.ws}.WukvT(), 2, 128, 1024, 1024, 1 << 30, 1 << 30, lds, tid);
  for (long u = gt; u < 16384L * 32; u += nth) {
    const int pos = (int)(u >> 5), i = (int)(u & 31);
    const double inv = exp2(-(double)i * (13.287712379549449 / 32.0));
    const float ang = (float)pos * (float)inv;
    const double a = (double)ang;
    const double n = rint(a * 0.15915494309189535);
    double r = fma(-n, 6.283185307179586, a);
    r = fma(-n, 2.4492935982947064e-16, r);
    const double r2 = r * r;
    double sn = r, cs = 1.0, ts = r, tc = 1.0;
#pragma unroll
    for (int k = 1; k <= 16; ++k) {
      tc = -tc * r2 * (1.0 / (double)((2 * k - 1) * (2 * k)));
      ts = -ts * r2 * (1.0 / (double)((2 * k) * (2 * k + 1)));
      cs += tc; sn += ts;
    }
    WS{P.ws}.rope()[u] = make_float2((float)cs, (float)sn);
  }
  if (blockIdx.x == 1) {
    float* cst = WS{P.ws}.consts();
    for (int l = 0; l < 2; ++l) {
      if (tid < 64) { cst[l * 1024 + 64 + tid] = P.a_q_norm[l * 64 + tid]; cst[l * 1024 + 128 + tid] = P.a_k_norm[l * 64 + tid]; }
      if (tid < 128) cst[l * 1024 + 192 + tid] = P.a_subln[l * 128 + tid];
      if (tid < 192) { cst[l * 1024 + 320 + tid] = P.b_q_norm[l * 192 + tid]; cst[l * 1024 + 512 + tid] = P.b_k_norm[l * 192 + tid]; }
    }
  }
  if (blockIdx.x == 0 && tid < 2) {
    const int l = tid;
    float d1 = 0.f, d2 = 0.f, gq = 0.f, gk = 0.f, bq = 0.f, bk = 0.f;
    for (int i = 0; i < 64; ++i) {
      d1 += P.a_lq1[l * 64 + i] * P.a_lk1[l * 64 + i];
      d2 += P.a_lq2[l * 64 + i] * P.a_lk2[l * 64 + i];
      gq = fmaxf(gq, fabsf(P.a_q_norm[l * 64 + i])); gk = fmaxf(gk, fabsf(P.a_k_norm[l * 64 + i]));
    }
    for (int i = 0; i < 192; ++i) { bq = fmaxf(bq, fabsf(P.b_q_norm[l * 192 + i])); bk = fmaxf(bk, fabsf(P.b_k_norm[l * 192 + i])); }
    const float lam_init = l == 0 ? 0.2f : 0.35550907f;
    WS{P.ws}.consts()[l * 1024 + 0] = expf(d1) - expf(d2) + lam_init;
    WS{P.ws}.consts()[l * 1024 + 1] = 8.f * gq * gk * LOG2E;
    WS{P.ws}.consts()[l * 1024 + 2] = 13.856406460551018f * bq * bk * LOG2E;
    WS{P.ws}.consts()[l * 1024 + 3] = lam_init;
  }
}

DEV void glds16(const u16* g, char* l) { __builtin_amdgcn_global_load_lds((const unsigned*)g, (unsigned*)l, 16, 0, 0); }
DEV int swz128(int row, int chunk) { return row * 128 + ((chunk ^ ((row >> 1) & 7)) << 4); }

enum { EPI_IN = 0, EPI_UQ = 1, EPI_UKV = 2, EPI_OUT = 3 };

template <int MI, int NI> struct Acc { f32x16 a[MI][NI]; };

DEV void st4bf(u16* dst, float a, float b, float c, float d) {
  u32x2 o = {cvtpk(a, b), cvtpk(c, d)};
  *reinterpret_cast<u32x2*>(dst) = o;
}

#define LDSP(T) __attribute__((address_space(3))) T*
DEV void st4lds(char* rowbase, int col, float a, float b, float c, float d) {
  u32x2 o = {cvtpk(a, b), cvtpk(c, d)};
  *(LDSP(u32x2))(rowbase + col * 2) = o;
}
template <int NCH, int STRIDE> DEV void slab_flush(char* slab, u16* grow0, int gstride, int lane) {
  asm volatile("s_waitcnt lgkmcnt(0)" ::: "memory");
#pragma unroll
  for (int i = 0; i < NCH / 2; ++i) {
    const int q = i * 64 + lane, row = q / NCH, cc = q - row * NCH;
    const u32x4 v = *(LDSP(const u32x4))(slab + row * STRIDE + cc * 16);
    *reinterpret_cast<u32x4*>(grow0 + (long)row * gstride + cc * 8) = v;
  }
  asm volatile("s_waitcnt lgkmcnt(0)" ::: "memory");
}

DEV void epi_inproj(f32x16 (&acc)[2][4], const Params& P, int layer, int batch, int m0, int nt, int wm, int wn, int r32, int hi, char* lds) {
  char* slab = lds + (wm * 2 + wn) * 8704; char* dst = slab + r32 * 272;
  const int lane = hi * 32 + r32;
#pragma unroll
  for (int mi = 0; mi < 2; ++mi) {
    const int t = m0 + wm * 64 + mi * 32 + r32;
    const long t0 = m0 + wm * 64 + mi * 32;
    u16* gdst; int gstr;
    float ss = 0.f;
#pragma unroll
    for (int j = 0; j < 8; ++j) ss += WS{P.ws}.ssq_x()[((long)batch * 8 + j) * TB + t];
    const float rstd = __builtin_amdgcn_rsqf(ss * (1.f / 1024.f) + EPS);
#pragma unroll
    for (int ni = 0; ni < 4; ++ni)
#pragma unroll
      for (int r = 0; r < 16; ++r) acc[mi][ni][r] *= rstd;
    if (nt < 4) {
      const float* g = WS{P.ws}.consts() + layer * 1024 + (nt < 2 ? 64 : 128);
      const float sc = nt < 2 ? 0.125f * LOG2E : 1.f;
      gdst = (nt < 2 ? WS{P.ws}.QA() : WS{P.ws}.KA()) + t0 * 512 + (nt & 1) * 256 + wn * 128; gstr = 512;
#pragma unroll
      for (int grp = 0; grp < 2; ++grp) {
        float s = 0.f;
#pragma unroll
        for (int b = 0; b < 2; ++b)
#pragma unroll
          for (int r = 0; r < 16; ++r) s += acc[mi][grp * 2 + b][r] * acc[mi][grp * 2 + b][r];
        s = swapsum(s);
        const float inv = __builtin_amdgcn_rsqf(s * (1.f / 64.f) + EPS) * sc;
#pragma unroll
        for (int b = 0; b < 2; ++b)
#pragma unroll
          for (int r4 = 0; r4 < 4; ++r4) {
            const int c = b * 32 + r4 * 8 + hi * 4;
            const float4 gg = *reinterpret_cast<const float4*>(g + c);
            const f32x16& a = acc[mi][grp * 2 + b];
            st4lds(dst, grp * 64 + c, a[r4 * 4] * inv * gg.x, a[r4 * 4 + 1] * inv * gg.y, a[r4 * 4 + 2] * inv * gg.z, a[r4 * 4 + 3] * inv * gg.w);
          }
      }
    } else if (nt < 6) {
      gdst = WS{P.ws}.VA() + t0 * 512 + (nt & 1) * 256 + wn * 128; gstr = 512;
#pragma unroll
      for (int ni = 0; ni < 4; ++ni)
#pragma unroll
        for (int r4 = 0; r4 < 4; ++r4) {
          const f32x16& a = acc[mi][ni];
          st4lds(dst, ni * 32 + r4 * 8 + hi * 4, a[r4 * 4], a[r4 * 4 + 1], a[r4 * 4 + 2], a[r4 * 4 + 3]);
        }
    } else if (nt < 8 || nt >= 10) {
      gdst = WS{P.ws}.G() + t0 * 1024 + (nt >= 10 ? 512 + (nt - 10) * 256 : (nt - 6) * 256) + wn * 128; gstr = 1024;
#pragma unroll
      for (int ni = 0; ni < 4; ++ni)
#pragma unroll
        for (int r4 = 0; r4 < 4; ++r4) {
          const f32x16& a = acc[mi][ni];
          st4lds(dst, ni * 32 + r4 * 8 + hi * 4, siluf(a[r4 * 4]), siluf(a[r4 * 4 + 1]), siluf(a[r4 * 4 + 2]), siluf(a[r4 * 4 + 3]));
        }
    } else if (nt == 8) {
      gdst = WS{P.ws}.CQ() + t0 * 256 + wn * 128; gstr = 256;
      float s = 0.f;
#pragma unroll
      for (int ni = 0; ni < 4; ++ni) {
        const f32x16& a = acc[mi][ni];
#pragma unroll
        for (int r = 0; r < 16; ++r) s += a[r] * a[r];
#pragma unroll
        for (int r4 = 0; r4 < 4; ++r4) st4lds(dst, ni * 32 + r4 * 8 + hi * 4, a[r4 * 4], a[r4 * 4 + 1], a[r4 * 4 + 2], a[r4 * 4 + 3]);
      }
      s = swapsum(s);
      if (hi == 0) WS{P.ws}.ssq_cq()[(long)wn * TB + t] = s;
    } else {
      if (wn == 0) {
        gdst = WS{P.ws}.CKV() + t0 * 128; gstr = 128;
        float s = 0.f;
#pragma unroll
        for (int ni = 0; ni < 4; ++ni) {
          const f32x16& a = acc[mi][ni];
#pragma unroll
          for (int r = 0; r < 16; ++r) s += a[r] * a[r];
#pragma unroll
          for (int r4 = 0; r4 < 4; ++r4) st4lds(dst, ni * 32 + r4 * 8 + hi * 4, a[r4 * 4], a[r4 * 4 + 1], a[r4 * 4 + 2], a[r4 * 4 + 3]);
        }
        s = swapsum(s);
        if (hi == 0) WS{P.ws}.ssq_ckv()[t] = s;
      } else {
        gdst = reinterpret_cast<u16*>(WS{P.ws}.KR() + t0 * 64); gstr = 128;
#pragma unroll
        for (int ni = 0; ni < 2; ++ni)
#pragma unroll
          for (int r4 = 0; r4 < 4; ++r4) {
            const f32x16& a = acc[mi][ni];
            *(LDSP(f32x4))(dst + (ni * 32 + r4 * 8 + hi * 4) * 4) = f32x4{a[r4 * 4], a[r4 * 4 + 1], a[r4 * 4 + 2], a[r4 * 4 + 3]};
          }
      }
    }
    slab_flush<16, 272>(slab, gdst, gstr, lane);
  }
}

DEV void epi_uq(f32x16 (&acc)[1][6], const Params& P, int layer, int batch, int m0, int head, int wid, int r32, int hi, char* lds) {
  const int t = m0 + wid * 32 + r32;
  const float rc = __builtin_amdgcn_rsqf((WS{P.ws}.ssq_cq()[t] + WS{P.ws}.ssq_cq()[TB + t] + WS{P.ws}.ssq_cq()[2 * TB + t] + WS{P.ws}.ssq_cq()[3 * TB + t]) * (1.f / 256.f) + EPS);
  float s = 0.f;
#pragma unroll
  for (int ni = 0; ni < 6; ++ni)
#pragma unroll
    for (int r = 0; r < 16; ++r) { acc[0][ni][r] *= rc; s += acc[0][ni][r] * acc[0][ni][r]; }
  s = swapsum(s);
  constexpr float SCQ = 0.07216878364870323f * LOG2E;
  const float inv = __builtin_amdgcn_rsqf(s * (1.f / 192.f) + EPS) * SCQ;
  const float* g = WS{P.ws}.consts() + layer * 1024 + 320;
  char* slab = lds + wid * 12800; char* dst = slab + r32 * 400;
#pragma unroll
  for (int ni = 0; ni < 4; ++ni)
#pragma unroll
    for (int r4 = 0; r4 < 4; ++r4) {
      const int c = ni * 32 + r4 * 8 + hi * 4;
      const float4 gg = *reinterpret_cast<const float4*>(g + c);
      const f32x16& a = acc[0][ni];
      st4lds(dst, c, a[r4 * 4] * inv * gg.x, a[r4 * 4 + 1] * inv * gg.y, a[r4 * 4 + 2] * inv * gg.z, a[r4 * 4 + 3] * inv * gg.w);
    }
  const int pos = batch ? t : (t & 4095);
  const float2* rp = WS{P.ws}.rope() + (long)pos * 32;
#pragma unroll
  for (int r4 = 0; r4 < 4; ++r4) {
    const int i = r4 * 8 + hi * 4;
    const float4 g1 = *reinterpret_cast<const float4*>(g + 128 + i), g2 = *reinterpret_cast<const float4*>(g + 160 + i);
    const float4 cs01 = *reinterpret_cast<const float4*>(rp + i), cs23 = *reinterpret_cast<const float4*>(rp + i + 2);
    const float x1[4] = {acc[0][4][r4 * 4] * inv * g1.x, acc[0][4][r4 * 4 + 1] * inv * g1.y, acc[0][4][r4 * 4 + 2] * inv * g1.z, acc[0][4][r4 * 4 + 3] * inv * g1.w};
    const float x2[4] = {acc[0][5][r4 * 4] * inv * g2.x, acc[0][5][r4 * 4 + 1] * inv * g2.y, acc[0][5][r4 * 4 + 2] * inv * g2.z, acc[0][5][r4 * 4 + 3] * inv * g2.w};
    const float cc[4] = {cs01.x, cs01.z, cs23.x, cs23.z}, sn[4] = {cs01.y, cs01.w, cs23.y, cs23.w};
    st4lds(dst, 128 + i, x1[0] * cc[0] - x2[0] * sn[0], x1[1] * cc[1] - x2[1] * sn[1], x1[2] * cc[2] - x2[2] * sn[2], x1[3] * cc[3] - x2[3] * sn[3]);
    st4lds(dst, 160 + i, x1[0] * sn[0] + x2[0] * cc[0], x1[1] * sn[1] + x2[1] * cc[1], x1[2] * sn[2] + x2[2] * cc[2], x1[3] * sn[3] + x2[3] * cc[3]);
  }
  slab_flush<24, 400>(slab, WS{P.ws}.QB() + (long)(m0 + wid * 32) * 768 + head * 192, 768, hi * 32 + r32);
}

DEV void epi_ukv(f32x16 (&acc)[1][8], const Params& P, int layer, int batch, int m0, int head, int wid, int r32, int hi, char* lds) {
  const int t = m0 + wid * 32 + r32;
  const float rc = __builtin_amdgcn_rsqf((WS{P.ws}.ssq_ckv()[t] + WS{P.ws}.ssq_ckv()[TB + t]) * (1.f / 128.f) + EPS);
  char* slab = lds + wid * 12800; char* vdst = slab + r32 * 272;
#pragma unroll
  for (int ni = 4; ni < 8; ++ni)
#pragma unroll
    for (int r4 = 0; r4 < 4; ++r4) {
      const f32x16& a = acc[0][ni];
      st4lds(vdst, (ni - 4) * 32 + r4 * 8 + hi * 4, a[r4 * 4] * rc, a[r4 * 4 + 1] * rc, a[r4 * 4 + 2] * rc, a[r4 * 4 + 3] * rc);
    }
  slab_flush<16, 272>(slab, WS{P.ws}.VB() + (long)(m0 + wid * 32) * 512 + head * 128, 512, hi * 32 + r32);
  float s = 0.f;
#pragma unroll
  for (int ni = 0; ni < 4; ++ni)
#pragma unroll
    for (int r = 0; r < 16; ++r) { acc[0][ni][r] *= rc; s += acc[0][ni][r] * acc[0][ni][r]; }
  float4 kr[2][4];
#pragma unroll
  for (int b = 0; b < 2; ++b)
#pragma unroll
    for (int r4 = 0; r4 < 4; ++r4) {
      kr[b][r4] = *reinterpret_cast<const float4*>(WS{P.ws}.KR() + (long)t * 64 + b * 32 + r4 * 8 + hi * 4);
      s += kr[b][r4].x * kr[b][r4].x + kr[b][r4].y * kr[b][r4].y + kr[b][r4].z * kr[b][r4].z + kr[b][r4].w * kr[b][r4].w;
    }
  s = swapsum(s);
  const float inv = __builtin_amdgcn_rsqf(s * (1.f / 192.f) + EPS);
  const float* g = WS{P.ws}.consts() + layer * 1024 + 512;
  char* dst = slab + r32 * 400;
#pragma unroll
  for (int ni = 0; ni < 4; ++ni)
#pragma unroll
    for (int r4 = 0; r4 < 4; ++r4) {
      const int c = ni * 32 + r4 * 8 + hi * 4;
      const float4 gg = *reinterpret_cast<const float4*>(g + c);
      const f32x16& a = acc[0][ni];
      st4lds(dst, c, a[r4 * 4] * inv * gg.x, a[r4 * 4 + 1] * inv * gg.y, a[r4 * 4 + 2] * inv * gg.z, a[r4 * 4 + 3] * inv * gg.w);
    }
  const int pos = batch ? t : (t & 4095);
  const float2* rp = WS{P.ws}.rope() + (long)pos * 32;
#pragma unroll
  for (int r4 = 0; r4 < 4; ++r4) {
    const int i = r4 * 8 + hi * 4;
    const float4 g1 = *reinterpret_cast<const float4*>(g + 128 + i), g2 = *reinterpret_cast<const float4*>(g + 160 + i);
    const float4 cs01 = *reinterpret_cast<const float4*>(rp + i), cs23 = *reinterpret_cast<const float4*>(rp + i + 2);
    const float x1[4] = {kr[0][r4].x * inv * g1.x, kr[0][r4].y * inv * g1.y, kr[0][r4].z * inv * g1.z, kr[0][r4].w * inv * g1.w};
    const float x2[4] = {kr[1][r4].x * inv * g2.x, kr[1][r4].y * inv * g2.y, kr[1][r4].z * inv * g2.z, kr[1][r4].w * inv * g2.w};
    const float cc[4] = {cs01.x, cs01.z, cs23.x, cs23.z}, sn[4] = {cs01.y, cs01.w, cs23.y, cs23.w};
    st4lds(dst, 128 + i, x1[0] * cc[0] - x2[0] * sn[0], x1[1] * cc[1] - x2[1] * sn[1], x1[2] * cc[2] - x2[2] * sn[2], x1[3] * cc[3] - x2[3] * sn[3]);
    st4lds(dst, 160 + i, x1[0] * sn[0] + x2[0] * cc[0], x1[1] * sn[1] + x2[1] * cc[1], x1[2] * sn[2] + x2[2] * cc[2], x1[3] * sn[3] + x2[3] * cc[3]);
  }
  slab_flush<24, 400>(slab, WS{P.ws}.KB() + (long)(m0 + wid * 32) * 768 + head * 192, 768, hi * 32 + r32);
}

DEV void epi_outproj(f32x16 (&acc)[2][4], const Params& P, int layer, int batch, int m0, int nt, int wm, int wn, int r32, int hi, char* lds) {
  const int lane = hi * 32 + r32, wid = wm * 2 + wn;
  float* T = reinterpret_cast<float*>(lds) + wid * (32 * 132);
  const int c = (lane & 31) * 4, n = nt * 256 + wn * 128 + c;
#pragma unroll
  for (int mi = 0; mi < 2; ++mi) {
#pragma unroll
    for (int ni = 0; ni < 4; ++ni)
#pragma unroll
      for (int r4 = 0; r4 < 4; ++r4) {
        const f32x16& a = acc[mi][ni];
        *reinterpret_cast<float4*>(T + r32 * 132 + ni * 32 + r4 * 8 + hi * 4) = make_float4(a[r4 * 4], a[r4 * 4 + 1], a[r4 * 4 + 2], a[r4 * 4 + 3]);
      }
    asm volatile("s_waitcnt lgkmcnt(0)" ::: "memory");
#pragma unroll 4
    for (int i = 0; i < 16; ++i) {
      const int tl = 2 * i + (lane >> 5), t = m0 + wm * 64 + mi * 32 + tl;
      const long tg = (long)batch * TB + t;
      const float4 a = *reinterpret_cast<const float4*>(T + tl * 132 + c);
      const float* xr = layer == 0 ? (batch ? P.xin1 : P.xin0) + (long)t * DM + n : P.out + tg * DM + n;
      const float4 xv = *reinterpret_cast<const float4*>(xr);
      const float4 o = make_float4(xv.x + a.x, xv.y + a.y, xv.z + a.z, xv.w + a.w);
      *reinterpret_cast<float4*>(P.out + tg * DM + n) = o;
      if (layer == 0) {
        st4bf(WS{P.ws}.XB() + tg * DM + n, o.x, o.y, o.z, o.w);
        float s = o.x * o.x + o.y * o.y + o.z * o.z + o.w * o.w;
#define SWZX(k) s += __int_as_float(__builtin_amdgcn_ds_swizzle(__float_as_int(s), ((k) << 10) | 0x1F))
        SWZX(1); SWZX(2); SWZX(4); SWZX(8); SWZX(16);
#undef SWZX
        if ((lane & 31) == 0) WS{P.ws}.ssq_x()[((long)batch * 8 + nt * 2 + wn) * TB + t] = s;
      }
    }
    asm volatile("s_waitcnt lgkmcnt(0)" ::: "memory");
  }
}

template <int WM, int WN, int BN, int EPI>
DEV void gemm_tile(const u16* __restrict__ A, int lda, const u16* __restrict__ Bt, int ldb, int K, int m0, char* lds,
                   const Params& P, int layer, int batch, int nt) {
  constexpr int MI = 256 / WM / 32, NI = BN / WN / 32, NB = BN / 64;
  const int tid = opaque_tid(), wid = tid >> 6, lane = tid & 63, r32 = lane & 31, hi = lane >> 5;
  const int wm = wid / WN, wn = wid % WN;
  char* As = lds; char* Bs = lds + 65536;
  f32x16 acc[MI][NI];
#pragma unroll
  for (int mi = 0; mi < MI; ++mi)
#pragma unroll
    for (int ni = 0; ni < NI; ++ni) acc[mi][ni] = f32x16{};
  const int srow = tid >> 3, sch = (tid & 7) ^ ((srow >> 1) & 7);
  const u16* Ap = A + (long)(m0 + srow) * lda + sch * 8;
  const u16* Bp = Bt + (long)srow * ldb + sch * 8;
  const int soff = tid * 16;
#define GLOAD(kt, buf) do { _Pragma("unroll") for (int i = 0; i < 4; ++i) glds16(Ap + (long)i * 64 * lda + (kt) * 64, As + (buf) * 32768 + soff + i * 8192); \
    _Pragma("unroll") for (int i = 0; i < NB; ++i) glds16(Bp + (long)i * 64 * ldb + (kt) * 64, Bs + (buf) * 32768 + soff + i * 8192); } while (0)
  GLOAD(0, 0); asm volatile("s_waitcnt vmcnt(0)" ::: "memory"); __syncthreads();
  const int nk = K >> 6;
  for (int kt = 0; kt < nk; ++kt) {
    const bool more = kt + 1 < nk;
    const int nb = (kt + 1) & 1;
    const char* as = As + (kt & 1) * 32768; const char* bs = Bs + (kt & 1) * 32768;
#pragma unroll
    for (int ks = 0; ks < 4; ++ks) {
      if (more) { glds16(Ap + (long)ks * 64 * lda + (kt + 1) * 64, As + nb * 32768 + soff + ks * 8192);
                  if (ks < NB) glds16(Bp + (long)ks * 64 * ldb + (kt + 1) * 64, Bs + nb * 32768 + soff + ks * 8192); }
      SBAR();
      bf16x8 xf[MI], wf[NI];
#pragma unroll
      for (int mi = 0; mi < MI; ++mi) xf[mi] = *reinterpret_cast<const bf16x8*>(as + swz128(wm * (MI * 32) + mi * 32 + r32, ks * 2 + hi));
#pragma unroll
      for (int ni = 0; ni < NI; ++ni) wf[ni] = *reinterpret_cast<const bf16x8*>(bs + swz128(wn * (NI * 32) + ni * 32 + r32, ks * 2 + hi));
#pragma unroll
      for (int mi = 0; mi < MI; ++mi)
#pragma unroll
        for (int ni = 0; ni < NI; ++ni) acc[mi][ni] = __builtin_amdgcn_mfma_f32_32x32x16_bf16(wf[ni], xf[mi], acc[mi][ni], 0, 0, 0);
    }
    asm volatile("s_waitcnt vmcnt(0)" ::: "memory");
    __syncthreads();
  }
#undef GLOAD
  if constexpr (EPI == EPI_IN) { epi_inproj(acc, P, layer, batch, m0, nt, wm, wn, r32, hi, lds); __syncthreads(); }
  else if constexpr (EPI == EPI_UQ) { epi_uq(acc, P, layer, batch, m0, nt, wid, r32, hi, lds); __syncthreads(); }
  else if constexpr (EPI == EPI_UKV) { epi_ukv(acc, P, layer, batch, m0, nt, wid, r32, hi, lds); __syncthreads(); }
  else { epi_outproj(acc, P, layer, batch, m0, nt, wm, wn, r32, hi, lds); __syncthreads(); }
}

DEV float red4(float s) { s += SWZ_XOR(s, 16); return swapsum(s); }
#define PG_LAS __attribute__((address_space(3)))
constexpr int PG_HTB = 128 * 64 * 2;
DEV int pg_lds_byte(int r, int c) { const int st = (r >> 4) * 2 + (c >> 5), rr = r & 15, cc = c & 31, ob = rr * 64 + cc * 2; return st * 1024 + (ob ^ (((ob >> 9) & 1) << 5)); }
DEV void pg_stage_rc(int b, int& R, int& C) { const int st = b / 1024, sb = b % 1024, swz = sb ^ (((sb >> 9) & 1) << 5); R = (st >> 1) * 16 + swz / 64; C = (st & 1) * 32 + (swz % 64) / 2; }
DEV int pg_perm32(int rho) { const int n = rho >> 4, i = rho & 15; return 8 * (i >> 2) + 4 * n + (i & 3); }
struct PgUnit { int pm, pn; };
struct PgOrder {
  int nM, nN, nwg, G, c;
  DEV void init(int M, int N, int G_, int c_) { nM = M / 256; nN = N / 256; nwg = nM * nN; G = G_; c = c_; }
  DEV bool next(int i, PgUnit& u) const {
    const long L = (long)i * G + c; if (L >= nwg) return false;
    int wgid = (int)L; { const int q = nwg / 8, r = nwg % 8, xcd = wgid % 8, off = wgid / 8; wgid = (xcd < r ? xcd * (q + 1) : r * (q + 1) + (xcd - r) * q) + off; }
    const int nig = 8 * nN, gid = wgid / nig, fm = gid * 8, gsz = (nM - fm) < 8 ? (nM - fm) : 8;
    u.pm = fm + ((wgid % nig) % gsz); u.pn = (wgid % nig) / gsz; return true;
  }
};

struct PgEpiIn {
  const Params* Pp; int layer, batch; const PG_LAS float* rl;
  DEV void operator()(f32x4 (&acc)[2][2][4][2], const PgUnit& u, int ui, int wr, int wc, int fr, int fq) const {
    const Params& P = *Pp; const int nt = u.pn;
    const float* g = WS{P.ws}.consts() + layer * 1024 + (nt < 2 ? 64 : 128);
    float4 gg[2][2];
    if (nt < 4) {
#pragma unroll
      for (int bj = 0; bj < 2; ++bj) { gg[bj][0] = *reinterpret_cast<const float4*>(g + bj * 32 + 8 * fq); gg[bj][1] = *reinterpret_cast<const float4*>(g + bj * 32 + 8 * fq + 4); }
    }
#pragma unroll
    for (int ai = 0; ai < 2; ++ai)
#pragma unroll
      for (int m = 0; m < 4; ++m) {
        const int t = u.pm * 256 + ai * 128 + wr * 64 + m * 16 + fr;
        float rstd;
        if (ui < 8) rstd = rl[ui * 256 + ai * 128 + wr * 64 + m * 16 + fr];
        else { float ss = 0.f;
#pragma unroll
          for (int j = 0; j < 16; ++j) ss += WS{P.ws}.ssq_x()[((long)batch * 16 + j) * TB + t];
          rstd = __builtin_amdgcn_rsqf(ss * (1.f / 1024.f) + EPS); }
        float v[2][8];
        float s = 0.f;
#pragma unroll
        for (int bj = 0; bj < 2; ++bj)
#pragma unroll
          for (int n = 0; n < 2; ++n)
#pragma unroll
            for (int r = 0; r < 4; ++r) { const float x = acc[ai][bj][m][n][r] * rstd; v[bj][n * 4 + r] = x; s += x * x; }
        if (nt < 4) {
          s = red4(s);
          const float inv = __builtin_amdgcn_rsqf(s * (1.f / 64.f) + EPS) * (nt < 2 ? 0.125f * LOG2E : 1.f);
          u16* dst = (nt < 2 ? WS{P.ws}.QA() : WS{P.ws}.KA()) + (long)t * 512 + (nt & 1) * 256 + wc * 64;
#pragma unroll
          for (int bj = 0; bj < 2; ++bj) {
            const int c8 = bj * 32 + 8 * fq;
            const float4 g0 = gg[bj][0], g1 = gg[bj][1];
            float y[8] = {v[bj][0] * inv * g0.x, v[bj][1] * inv * g0.y, v[bj][2] * inv * g0.z, v[bj][3] * inv * g0.w, v[bj][4] * inv * g1.x, v[bj][5] * inv * g1.y, v[bj][6] * inv * g1.z, v[bj][7] * inv * g1.w};
            store8bf(dst + c8, y);
          }
        } else if (nt < 6) {
          u16* dst = WS{P.ws}.VA() + (long)t * 512 + (nt & 1) * 256 + wc * 64;
#pragma unroll
          for (int bj = 0; bj < 2; ++bj) store8bf(dst + bj * 32 + 8 * fq, v[bj]);
        } else if (nt < 8 || nt >= 10) {
          u16* dst = WS{P.ws}.G() + (long)t * 1024 + (nt >= 10 ? 512 + (nt - 10) * 256 : (nt - 6) * 256) + wc * 64;
#pragma unroll
          for (int bj = 0; bj < 2; ++bj) {
            float y[8];
#pragma unroll
            for (int e = 0; e < 8; ++e) y[e] = siluf(v[bj][e]);
            store8bf(dst + bj * 32 + 8 * fq, y);
          }
        } else if (nt == 8) {
          u16* dst = WS{P.ws}.CQ() + (long)t * 256 + wc * 64;
#pragma unroll
          for (int bj = 0; bj < 2; ++bj) store8bf(dst + bj * 32 + 8 * fq, v[bj]);
          s = red4(s);
          if (fq == 0) WS{P.ws}.ssq_cq()[(long)wc * TB + t] = s;
        } else if (wc < 2) {
          u16* dst = WS{P.ws}.CKV() + (long)t * 128 + wc * 64;
#pragma unroll
          for (int bj = 0; bj < 2; ++bj) store8bf(dst + bj * 32 + 8 * fq, v[bj]);
          s = red4(s);
          if (fq == 0) WS{P.ws}.ssq_ckv()[(long)wc * TB + t] = s;
        } else if (wc == 2) {
          float* dst = WS{P.ws}.KR() + (long)t * 64;
#pragma unroll
          for (int bj = 0; bj < 2; ++bj) {
            *reinterpret_cast<float4*>(dst + bj * 32 + 8 * fq) = make_float4(v[bj][0], v[bj][1], v[bj][2], v[bj][3]);
            *reinterpret_cast<float4*>(dst + bj * 32 + 8 * fq + 4) = make_float4(v[bj][4], v[bj][5], v[bj][6], v[bj][7]);
          }
        }
      }
  }
};

struct PgEpiOut {
  const Params* Pp; int layer, batch;
  DEV void operator()(f32x4 (&acc)[2][2][4][2], const PgUnit& u, int ui, int wr, int wc, int fr, int fq) const {
    const Params& P = *Pp; const int nt = u.pn;
    const int n0 = nt * 256 + wc * 64 + 8 * fq;
#pragma unroll
    for (int ai = 0; ai < 2; ++ai) {
      float4 xv[4][2][2];
#pragma unroll
      for (int m = 0; m < 4; ++m) {
        const int t = u.pm * 256 + ai * 128 + wr * 64 + m * 16 + fr;
        const float* xr = layer == 0 ? (batch ? P.xin1 : P.xin0) + (long)t * DM + n0 : P.out + ((long)batch * TB + t) * DM + n0;
#pragma unroll
        for (int bj = 0; bj < 2; ++bj) { xv[m][bj][0] = *reinterpret_cast<const float4*>(xr + bj * 32); xv[m][bj][1] = *reinterpret_cast<const float4*>(xr + bj * 32 + 4); }
      }
#pragma unroll
      for (int m = 0; m < 4; ++m) {
        const int t = u.pm * 256 + ai * 128 + wr * 64 + m * 16 + fr;
        const long tg = (long)batch * TB + t;
        float s = 0.f;
#pragma unroll
        for (int bj = 0; bj < 2; ++bj) {
          const int n = n0 + bj * 32;
          const float4 x0 = xv[m][bj][0], x1 = xv[m][bj][1];
          const f32x4 a0 = acc[ai][bj][m][0], a1 = acc[ai][bj][m][1];
          float o[8] = {x0.x + a0[0], x0.y + a0[1], x0.z + a0[2], x0.w + a0[3], x1.x + a1[0], x1.y + a1[1], x1.z + a1[2], x1.w + a1[3]};
          *reinterpret_cast<float4*>(P.out + tg * DM + n) = make_float4(o[0], o[1], o[2], o[3]);
          *reinterpret_cast<float4*>(P.out + tg * DM + n + 4) = make_float4(o[4], o[5], o[6], o[7]);
          if (layer == 0) {
            store8bf(WS{P.ws}.XB() + tg * DM + n, o);
#pragma unroll
            for (int e = 0; e < 8; ++e) s += o[e] * o[e];
          }
        }
        if (layer == 0) { s = red4(s); if (fq == 0) WS{P.ws}.ssq_x()[((long)batch * 16 + nt * 4 + wc) * TB + t] = s; }
      }
    }
  }
};

template <class Epi>
DEV void pg_gemm_phase(PG_LAS unsigned char* lds, const u16* gA, const u16* gBt, int M, int N, int K, const PgOrder& S, const Epi& E) {
  const int tid = opaque_tid(), wid = __builtin_amdgcn_readfirstlane(tid >> 6), lane = tid & 63, wr = wid >> 2, wc = wid & 3, fr = lane & 15, fq = lane >> 4;
  const int nt = K / 64;
  unsigned voffA[2], voffB[2];
#pragma unroll
  for (int i = 0; i < 2; ++i) { int R, C; pg_stage_rc(tid * 16 + i * 8192, R, C);
    const int Rb = (R >> 5) * 64 + pg_perm32(R & 31);
    voffA[i] = (unsigned)(R * K + C) * 2u; voffB[i] = (unsigned)(Rb * K + C) * 2u; }
  const size_t kstep = (size_t)(64 * 2);
  const size_t hstepA = (size_t)128 * K * 2, hstepB = (size_t)32 * K * 2;
  const size_t tstep = (size_t)256 * K * 2;
  const unsigned ldsw = (unsigned)wid * 1024u;
  const int aoff = pg_lds_byte(wr * 64 + fr, fq * 8), boff = pg_lds_byte(wc * 32 + fr, fq * 8);
#define PG_SA(b, h) (((b) * 2 + (h)) * PG_HTB)
#define PG_SB(b, h) ((4 + (b) * 2 + (h)) * PG_HTB)
#define PG_STAGE(bufoff, gbase, voff) do { _Pragma("unroll") for (int _i = 0; _i < 2; ++_i) \
    __builtin_amdgcn_global_load_lds((const unsigned*)((const char*)(gbase) + (voff)[_i]), (PG_LAS unsigned*)(lds + (bufoff) + ldsw + _i * 8192), 16, 0, 0); } while (0)
#define PG_LDA(dst, b, h) do { _Pragma("unroll") for (int m = 0; m < 4; ++m) _Pragma("unroll") for (int k = 0; k < 2; ++k) dst[m][k] = *(const PG_LAS bf16x8*)(lds + PG_SA(b, h) + aoff + m * 2048 + k * 1024); } while (0)
#define PG_LDB(dst, b, h) do { _Pragma("unroll") for (int n = 0; n < 2; ++n) _Pragma("unroll") for (int k = 0; k < 2; ++k) dst[n][k] = *(const PG_LAS bf16x8*)(lds + PG_SB(b, h) + boff + n * 2048 + k * 1024); } while (0)
#define PG_MMA(ai, bj, At, Bt) do { __builtin_amdgcn_s_setprio(1); _Pragma("unroll") for (int m = 0; m < 4; ++m) _Pragma("unroll") for (int n = 0; n < 2; ++n) _Pragma("unroll") for (int k = 0; k < 2; ++k) \
    acc[ai][bj][m][n] = __builtin_amdgcn_mfma_f32_16x16x32_bf16(Bt[n][k], At[m][k], acc[ai][bj][m][n], 0, 0, 0); __builtin_amdgcn_s_setprio(0); } while (0)
#define PG_WAIT_V(n) asm volatile("s_waitcnt vmcnt(" #n ")" ::: "memory")
#define PG_WAIT_L(n) asm volatile("s_waitcnt lgkmcnt(" #n ")" ::: "memory")
#define PG_BAR __builtin_amdgcn_s_barrier()
#define PG_SCHED __builtin_amdgcn_sched_barrier(0)
  PgUnit cur, nxt; int ui = 0;
  if (!S.next(0, cur)) return;
  f32x4 acc[2][2][4][2];
#pragma unroll
  for (int a = 0; a < 2; ++a)
#pragma unroll
    for (int b = 0; b < 2; ++b)
#pragma unroll
      for (int m = 0; m < 4; ++m)
#pragma unroll
        for (int n = 0; n < 2; ++n) acc[a][b][m][n] = (f32x4){0.f, 0.f, 0.f, 0.f};
  bf16x8 At[4][2], B0[2][2], B1[2][2];
  const char* cA = (const char*)gA + (size_t)cur.pm * tstep; const char* cB = (const char*)gBt + (size_t)cur.pn * tstep;
  PG_STAGE(PG_SB(0, 0), cB, voffB); PG_STAGE(PG_SA(0, 0), cA, voffA); PG_STAGE(PG_SB(0, 1), cB + hstepB, voffB); PG_STAGE(PG_SA(0, 1), cA + hstepA, voffA);
  if (wr == 1) PG_BAR;
  PG_WAIT_V(4); PG_BAR;
  PG_STAGE(PG_SB(1, 0), cB + kstep, voffB); PG_STAGE(PG_SA(1, 0), cA + kstep, voffA); PG_STAGE(PG_SB(1, 1), cB + hstepB + kstep, voffB);
  PG_WAIT_V(6); PG_BAR;
  for (;;) {
    const bool has_next = S.next(ui + 1, nxt);
    const char* nA = has_next ? (const char*)gA + (size_t)nxt.pm * tstep : cA; const char* nB = has_next ? (const char*)gBt + (size_t)nxt.pn * tstep : cB;
    for (int t = 0; t < nt; t += 2) {
      const bool last = (t == nt - 2);
      const char* a1 = cA + (size_t)(t + 1) * kstep;
      const char* a2 = last ? nA : cA + (size_t)(t + 2) * kstep; const char* b2 = last ? nB : cB + (size_t)(t + 2) * kstep;
      const char* a3 = a2 + kstep; const char* b3 = b2 + kstep;
      PG_LDB(B0, 0, 0); PG_SCHED; PG_LDA(At, 0, 0); PG_STAGE(PG_SA(1, 1), a1 + hstepA, voffA);
      PG_WAIT_L(8); PG_BAR; PG_WAIT_L(0); PG_MMA(0, 0, At, B0); PG_BAR; PG_SCHED;
      PG_LDB(B1, 0, 1); PG_STAGE(PG_SB(0, 0), b2, voffB);
      PG_BAR; PG_WAIT_L(0); PG_MMA(0, 1, At, B1); PG_BAR;
      PG_LDA(At, 0, 1); PG_STAGE(PG_SA(0, 0), a2, voffA);
      PG_BAR; PG_WAIT_L(0); PG_MMA(1, 0, At, B0); PG_BAR; PG_SCHED;
      PG_STAGE(PG_SB(0, 1), b2 + hstepB, voffB);
      PG_WAIT_V(6); PG_BAR; PG_MMA(1, 1, At, B1); PG_BAR;
      PG_LDB(B0, 1, 0); PG_SCHED; PG_LDA(At, 1, 0); PG_STAGE(PG_SA(0, 1), a2 + hstepA, voffA);
      PG_WAIT_L(8); PG_BAR; PG_WAIT_L(0); PG_MMA(0, 0, At, B0); PG_BAR; PG_SCHED;
      PG_LDB(B1, 1, 1); PG_STAGE(PG_SB(1, 0), b3, voffB);
      PG_BAR; PG_WAIT_L(0); PG_MMA(0, 1, At, B1); PG_BAR;
      PG_LDA(At, 1, 1); PG_STAGE(PG_SA(1, 0), a3, voffA);
      PG_BAR; PG_WAIT_L(0); PG_MMA(1, 0, At, B0); PG_BAR; PG_SCHED;
      PG_STAGE(PG_SB(1, 1), b3 + hstepB, voffB);
      PG_WAIT_V(6); PG_BAR; PG_MMA(1, 1, At, B1); PG_BAR;
    }
    E(acc, cur, ui, wr, wc, fr, fq);
    if (!has_next) break;
#pragma unroll
    for (int a = 0; a < 2; ++a)
#pragma unroll
      for (int b = 0; b < 2; ++b)
#pragma unroll
        for (int m = 0; m < 4; ++m)
#pragma unroll
          for (int n = 0; n < 2; ++n) acc[a][b][m][n] = (f32x4){0.f, 0.f, 0.f, 0.f};
    cur = nxt; cA = nA; cB = nB; ++ui;
  }
  PG_WAIT_V(0);
  if (wr == 0) PG_BAR;
  PG_BAR;
#undef PG_SA
#undef PG_SB
#undef PG_STAGE
#undef PG_LDA
#undef PG_LDB
#undef PG_MMA
#undef PG_WAIT_V
#undef PG_WAIT_L
#undef PG_BAR
#undef PG_SCHED
}

#define KSWZ(row, colB) ((row) * 256 + ((colB) ^ (((row) & 7) << 4)))
DEV int v_st(int k, int c) { const int kk = (k & ~0xC) | ((k & 4) << 1) | ((k & 8) >> 1); return ((kk >> 3) * 4 + (c >> 5)) * 512 + ((kk & 7) * 32 + (c & 31)) * 2; }
DEV int v_rd_base(int lane) { return ((lane & 3) << 3) | (((lane >> 2) & 3) << 6) | (((lane >> 4) & 1) << 5) | (((lane >> 5) & 1) << 8); }
constexpr int v_rd_off(int d0, int ks, int half) { return d0 * 512 + ks * 4096 + half * 2048; }
template <int OFF> DEV s16x4 tr_read(int vb) {
  s16x4 r; asm volatile("ds_read_b64_tr_b16 %0, %1 offset:%2" : "=&v"(r) : "v"(vb), "i"(OFF) : "memory"); return r;
}
#define SGB(mask, n) __builtin_amdgcn_sched_group_barrier(mask, n, 0)
template <int D0> DEV void tr8(int vb, s16x4 (&f)[8]) {
  f[0] = tr_read<v_rd_off(D0, 0, 0)>(vb); f[1] = tr_read<v_rd_off(D0, 0, 1)>(vb); f[2] = tr_read<v_rd_off(D0, 1, 0)>(vb); f[3] = tr_read<v_rd_off(D0, 1, 1)>(vb);
  f[4] = tr_read<v_rd_off(D0, 2, 0)>(vb); f[5] = tr_read<v_rd_off(D0, 2, 1)>(vb); f[6] = tr_read<v_rd_off(D0, 3, 0)>(vb); f[7] = tr_read<v_rd_off(D0, 3, 1)>(vb);
}
DEV void mma4(f32x16& od, const s16x4 (&f)[8], bf16x8 pa0, bf16x8 pa1, bf16x8 pa2, bf16x8 pa3) {
#define PK(L, H) (bf16x8){L[0], L[1], L[2], L[3], H[0], H[1], H[2], H[3]}
  od = __builtin_amdgcn_mfma_f32_32x32x16_bf16(pa0, PK(f[0], f[1]), od, 0, 0, 0);
  od = __builtin_amdgcn_mfma_f32_32x32x16_bf16(pa1, PK(f[2], f[3]), od, 0, 0, 0);
  od = __builtin_amdgcn_mfma_f32_32x32x16_bf16(pa2, PK(f[4], f[5]), od, 0, 0, 0);
  od = __builtin_amdgcn_mfma_f32_32x32x16_bf16(pa3, PK(f[6], f[7]), od, 0, 0, 0);
#undef PK
}
DEV void pv_d0(f32x16* o, int vb, bf16x8 pa0, bf16x8 pa1, bf16x8 pa2, bf16x8 pa3) {
  s16x4 fa[8], fb[8];
  tr8<0>(vb, fa); tr8<1>(vb, fb);
  asm volatile("s_waitcnt lgkmcnt(8)" ::: "memory"); SBAR();
  mma4(o[0], fa, pa0, pa1, pa2, pa3);
  tr8<2>(vb, fa);
  asm volatile("s_waitcnt lgkmcnt(8)" ::: "memory"); SBAR();
  mma4(o[1], fb, pa0, pa1, pa2, pa3);
  tr8<3>(vb, fb);
  asm volatile("s_waitcnt lgkmcnt(8)" ::: "memory"); SBAR();
  mma4(o[2], fa, pa0, pa1, pa2, pa3);
  asm volatile("s_waitcnt lgkmcnt(0)" ::: "memory"); SBAR();
  mma4(o[3], fb, pa0, pa1, pa2, pa3);
}
DEV void softmax_pack(f32x16& p0, f32x16& p1, float& lsum, bf16x8& pa0, bf16x8& pa1, bf16x8& pa2, bf16x8& pa3) {
#pragma unroll
  for (int r = 0; r < 16; ++r) { p0[r] = __builtin_amdgcn_exp2f(p0[r]); p1[r] = __builtin_amdgcn_exp2f(p1[r]); }
  float ps = 0.f;
#pragma unroll
  for (int r = 0; r < 16; ++r) ps += p0[r] + p1[r];
  lsum += ps;
#define PK4(Pv, BASE, OUT) do { unsigned a0 = cvtpk(Pv[BASE + 0], Pv[BASE + 1]), a1 = cvtpk(Pv[BASE + 2], Pv[BASE + 3]);   \
    unsigned b0 = cvtpk(Pv[BASE + 4], Pv[BASE + 5]), b1 = cvtpk(Pv[BASE + 6], Pv[BASE + 7]);                              \
    auto r0 = __builtin_amdgcn_permlane32_swap(a0, b0, false, false); auto r1 = __builtin_amdgcn_permlane32_swap(a1, b1, false, false); \
    u32x4 w = {r0[0], r1[0], r0[1], r1[1]}; OUT = *reinterpret_cast<bf16x8*>(&w); } while (0)
  PK4(p0, 0, pa0); PK4(p0, 8, pa1); PK4(p1, 0, pa2); PK4(p1, 8, pa3);
#undef PK4
}

DEV void sm_half(f32x16& p, float& lsum, bf16x8& paLo, bf16x8& paHi) {
#pragma unroll
  for (int r = 0; r < 16; ++r) p[r] = __builtin_amdgcn_exp2f(p[r]);
  float ps = 0.f;
#pragma unroll
  for (int r = 0; r < 16; ++r) ps += p[r];
  lsum += ps;
#define PK4(Pv, BASE, OUT) do { unsigned a0 = cvtpk(Pv[BASE + 0], Pv[BASE + 1]), a1 = cvtpk(Pv[BASE + 2], Pv[BASE + 3]);   \
    unsigned b0 = cvtpk(Pv[BASE + 4], Pv[BASE + 5]), b1 = cvtpk(Pv[BASE + 6], Pv[BASE + 7]);                              \
    auto r0 = __builtin_amdgcn_permlane32_swap(a0, b0, false, false); auto r1 = __builtin_amdgcn_permlane32_swap(a1, b1, false, false); \
    u32x4 w = {r0[0], r1[0], r0[1], r1[1]}; OUT = *reinterpret_cast<bf16x8*>(&w); } while (0)
  PK4(p, 0, paLo); PK4(p, 8, paHi);
#undef PK4
}
template <int KS0, int DA> DEV void trq(int vb, s16x4 (&f)[8]) {
  f[0] = tr_read<v_rd_off(DA, KS0, 0)>(vb); f[1] = tr_read<v_rd_off(DA, KS0, 1)>(vb); f[2] = tr_read<v_rd_off(DA, KS0 + 1, 0)>(vb); f[3] = tr_read<v_rd_off(DA, KS0 + 1, 1)>(vb);
  f[4] = tr_read<v_rd_off(DA + 1, KS0, 0)>(vb); f[5] = tr_read<v_rd_off(DA + 1, KS0, 1)>(vb); f[6] = tr_read<v_rd_off(DA + 1, KS0 + 1, 0)>(vb); f[7] = tr_read<v_rd_off(DA + 1, KS0 + 1, 1)>(vb);
}
DEV void mmaq(f32x16& oa, f32x16& ob, const s16x4 (&f)[8], bf16x8 paX, bf16x8 paY) {
#define PK(L, H) (bf16x8){L[0], L[1], L[2], L[3], H[0], H[1], H[2], H[3]}
  oa = __builtin_amdgcn_mfma_f32_32x32x16_bf16(paX, PK(f[0], f[1]), oa, 0, 0, 0);
  ob = __builtin_amdgcn_mfma_f32_32x32x16_bf16(paX, PK(f[4], f[5]), ob, 0, 0, 0);
  oa = __builtin_amdgcn_mfma_f32_32x32x16_bf16(paY, PK(f[2], f[3]), oa, 0, 0, 0);
  ob = __builtin_amdgcn_mfma_f32_32x32x16_bf16(paY, PK(f[6], f[7]), ob, 0, 0, 0);
#undef PK
}
DEV void sm_exp(f32x16& p, float& lsum) {
#pragma unroll
  for (int r = 0; r < 16; ++r) p[r] = __builtin_amdgcn_exp2f(p[r]);
#pragma unroll
  for (int r = 0; r < 16; ++r) lsum += p[r];
}
DEV void sm_pack(const f32x16& p, bf16x8& paLo, bf16x8& paHi) {
  u32x4 lo = {cvtpk(p[0], p[1]), cvtpk(p[2], p[3]), cvtpk(p[4], p[5]), cvtpk(p[6], p[7])};
  u32x4 hi = {cvtpk(p[8], p[9]), cvtpk(p[10], p[11]), cvtpk(p[12], p[13]), cvtpk(p[14], p[15])};
  paLo = *reinterpret_cast<bf16x8*>(&lo); paHi = *reinterpret_cast<bf16x8*>(&hi);
}

DEV void attn_a_item(const Params& P, int layer, int batch, int item, char* lds) {
  const int tid = opaque_tid(), wid = tid >> 6, lane = tid & 63, r32 = lane & 31, hi = lane >> 5;
  const int seqlen = batch ? 16384 : 4096;
  const int head = 3 - (item >> 7), k_ = item & 127;
  const int kk_ = batch ? k_ : (k_ >> 2), mid_ = batch ? 64 : 16;
  const int qb = mid_ + ((kk_ & 1) ? -((kk_ + 1) >> 1) : (kk_ >> 1));
  const int seq = batch ? 0 : (k_ & 3);
  const long tok0 = (long)seq * 4096;
  const int c = wid >> 2, wq = wid & 3;
  const int qpos = qb * 128 + wq * 32 + r32;
  char* V_lds = lds; char* K_lds = lds + 32768;
  float* wsl = reinterpret_cast<float*>(lds + LDS_WS) + wid * 64;
  const float lam = WS{P.ws}.consts()[layer * 1024 + 0], nMC = -WS{P.ws}.consts()[layer * 1024 + 1], lam_init = WS{P.ws}.consts()[layer * 1024 + 3];
  const float nslope = -exp2f(-2.f * (float)(head + 1)) * LOG2E;
  bf16x8 qr[4];
  {
    const u16* Qw = WS{P.ws}.QA() + (tok0 + qpos) * 512 + head * 128 + c * 64 + hi * 8;
#pragma unroll
    for (int ks = 0; ks < 4; ++ks) qr[ks] = *reinterpret_cast<const bf16x8*>(Qw + ks * 16);
  }
  const u16* Kh = WS{P.ws}.KA() + tok0 * 512 + head * 128;
  const u16* Vh = WS{P.ws}.VA() + tok0 * 512 + head * 128;
  int akoff[2], avoff[2], ldst[2];
#pragma unroll
  for (int i = 0; i < 2; ++i) {
    const int p = (wid + 8 * i) * 1024 + lane * 16;
    ldst[i] = p;
    const int row = p >> 8, cB = (p & 255) ^ ((row & 7) << 4);
    akoff[i] = row * 512 + (cB >> 1);
    const int st = p >> 9, within = p & 511, kk = (st >> 2) * 8 + (within >> 6);
    const int k = kk, col = (st & 3) * 32 + ((within & 63) >> 1);
    avoff[i] = k * 512 + col;
  }
  const int vb0 = (int)(uintptr_t)V_lds + v_rd_base(lane);
#define ALOAD(b, k0) do { _Pragma("unroll") for (int i = 0; i < 2; ++i) { glds16(Kh + (long)(k0) * 512 + akoff[i], K_lds + (b) * 16384 + ldst[i]); \
    glds16(Vh + (long)(k0) * 512 + avoff[i], V_lds + (b) * 16384 + ldst[i]); } } while (0)
  f32x16 o[4] = {f32x16{}, f32x16{}, f32x16{}, f32x16{}};
  float lsum = 0.f;
  const int NT = seqlen >> 6;
  const int Dk = (int)fminf(160.f / -nslope, 1.0e6f);
  const int jlo = max(0, (qb * 128 - Dk) >> 6), jhi = min(NT - 1, (qb * 128 + 127 + Dk) >> 6);
  ALOAD(0, jlo * 64); asm volatile("s_waitcnt vmcnt(0)" ::: "memory"); __syncthreads();
  for (int j = jlo; j <= jhi; ++j) {
    const int bcur = (j - jlo) & 1;
    if (j + 1 <= jhi) ALOAD(bcur ^ 1, (j + 1) * 64);
    const char* Ks = K_lds + bcur * 16384;
    f32x16 p0, p1;
    {
      const float dbase = (float)(j * 64 - qpos + 4 * hi);
      const int q0 = qb * 128;
      if (j * 64 + 63 < q0 || j * 64 > q0 + 127) {
        const float step = (j * 64 < q0) ? -nslope : nslope;
        const float base = fmaf(dbase, step, nMC), step8 = 8.f * step;
        p0[0] = base; p0[1] = base + step; p0[2] = fmaf(2.f, step, base); p0[3] = fmaf(3.f, step, base);
#pragma unroll
        for (int r = 4; r < 16; ++r) p0[r] = p0[r - 4] + step8;
#pragma unroll
        for (int r = 0; r < 4; ++r) p1[r] = p0[r + 12] + step8;
#pragma unroll
        for (int r = 4; r < 16; ++r) p1[r] = p1[r - 4] + step8;
      } else {
        float d0[16], d1[16];
        d0[0] = dbase; d0[1] = dbase + 1.f; d0[2] = dbase + 2.f; d0[3] = d0[1] + 2.f;
#pragma unroll
        for (int r = 4; r < 16; ++r) d0[r] = d0[r - 4] + 8.f;
#pragma unroll
        for (int r = 0; r < 4; ++r) d1[r] = d0[r + 12] + 8.f;
#pragma unroll
        for (int r = 4; r < 16; ++r) d1[r] = d1[r - 4] + 8.f;
#pragma unroll
        for (int r = 0; r < 16; ++r) { p0[r] = fmaf(fabsf(d0[r]), nslope, nMC); p1[r] = fmaf(fabsf(d1[r]), nslope, nMC); }
      }
    }
    const int vb = vb0 + bcur * 16384;
    bf16x8 pa0, pa1, pa2, pa3;
    s16x4 fa[8], fb[8];
    bf16x8 kf[8];
#pragma unroll
    for (int ks = 0; ks < 4; ++ks) {
      const int cb = c * 128 + (ks * 16 + hi * 8) * 2;
      kf[2 * ks] = *reinterpret_cast<const bf16x8*>(Ks + KSWZ(r32, cb));
      kf[2 * ks + 1] = *reinterpret_cast<const bf16x8*>(Ks + KSWZ(32 + r32, cb));
    }
#pragma unroll
    for (int ks = 0; ks < 4; ++ks) p0 = __builtin_amdgcn_mfma_f32_32x32x16_bf16(kf[2 * ks], qr[ks], p0, 0, 0, 0);
    SBAR();
    trq<0, 0>(vb, fa);
#pragma unroll
    for (int ks = 0; ks < 4; ++ks) p1 = __builtin_amdgcn_mfma_f32_32x32x16_bf16(kf[2 * ks + 1], qr[ks], p1, 0, 0, 0);
    sm_exp(p0, lsum); sm_pack(p0, pa0, pa1);
    asm volatile("s_waitcnt lgkmcnt(0)" ::: "memory"); SBAR();
    trq<0, 2>(vb, fb);
    mmaq(o[0], o[1], fa, pa0, pa1);
    sm_exp(p1, lsum);
    asm volatile("s_waitcnt lgkmcnt(0)" ::: "memory"); SBAR();
    trq<2, 0>(vb, fa);
    mmaq(o[2], o[3], fb, pa0, pa1);
    sm_pack(p1, pa2, pa3);
    asm volatile("s_waitcnt lgkmcnt(0)" ::: "memory"); SBAR();
    trq<2, 2>(vb, fb);
    mmaq(o[0], o[1], fa, pa2, pa3);
    asm volatile("s_waitcnt lgkmcnt(0)" ::: "memory"); SBAR();
    mmaq(o[2], o[3], fb, pa2, pa3);
    asm volatile("s_waitcnt vmcnt(0)" ::: "memory");
    __syncthreads();
  }
#undef ALOAD
  lsum = swapsum(lsum);
  if (hi == 0) wsl[r32] = (c ? lam : 1.f) / lsum;
  asm volatile("s_waitcnt lgkmcnt(0)" ::: "memory");
  float rli[16];
#pragma unroll
  for (int r = 0; r < 16; ++r) rli[r] = wsl[crow(r, hi)];
  float* Ob = reinterpret_cast<float*>(lds);
  if (c == 1) {
#pragma unroll
    for (int d0 = 0; d0 < 4; ++d0)
#pragma unroll
      for (int r = 0; r < 16; ++r) Ob[(wq * 32 + crow(r, hi)) * 132 + d0 * 32 + r32] = o[d0][r] * rli[r];
  }
  __syncthreads();
  if (c == 0) {
#pragma unroll
    for (int d0 = 0; d0 < 4; ++d0)
#pragma unroll
      for (int r = 0; r < 16; ++r) {
        float* p = &Ob[(wq * 32 + crow(r, hi)) * 132 + d0 * 32 + r32];
        *p = o[d0][r] * rli[r] - *p;
      }
  }
  __syncthreads();
  {
    const int row = tid >> 2, part = tid & 3;
    const float* src = Ob + row * 132 + part * 32;
    float v[32];
    float s = 0.f;
#pragma unroll
    for (int i = 0; i < 8; ++i) {
      const float4 x = *reinterpret_cast<const float4*>(src + i * 4);
      v[i * 4] = x.x; v[i * 4 + 1] = x.y; v[i * 4 + 2] = x.z; v[i * 4 + 3] = x.w;
      s += x.x * x.x + x.y * x.y + x.z * x.z + x.w * x.w;
    }
    s += SWZ_XOR(s, 1); s += SWZ_XOR(s, 2);
    const float inv = __builtin_amdgcn_rsqf(s * (1.f / 128.f) + EPS) * (1.f - lam_init);
    const float* sg = WS{P.ws}.consts() + layer * 1024 + 192 + part * 32;
    u16* gp = WS{P.ws}.G() + (tok0 + qb * 128 + row) * 1024 + head * 128 + part * 32;
#pragma unroll
    for (int i = 0; i < 4; ++i) {
      const u32x4 gw = *reinterpret_cast<const u32x4*>(gp + i * 8);
      float y[8];
#pragma unroll
      for (int e = 0; e < 8; ++e) {
        const unsigned w = gw[e >> 1];
        const float gate = (e & 1) ? __uint_as_float(w & 0xffff0000u) : __uint_as_float(w << 16);
        y[e] = v[i * 8 + e] * inv * sg[i * 8 + e] * gate;
      }
      store8bf(gp + i * 8, y);
    }
  }
  __syncthreads();
}

DEV void attn_b_item(const Params& P, int layer, int batch, int item, char* lds) {
  const int tid = opaque_tid(), wid = tid >> 6, lane = tid & 63, r32 = lane & 31, hi = lane >> 5;
  const int seqlen = batch ? 16384 : 4096;
  const int xcd = item & 7, jj = item >> 3;
  const int sh = batch ? (xcd >> 1) : (2 * xcd + (jj >> 4));
  const int qb = batch ? ((xcd & 1) * 32 + jj) : (jj & 15);
  const int head = sh & 3, seq = sh >> 2;
  const long tok0 = (long)seq * 4096;
  const int qpos = qb * 256 + wid * 32 + r32;
  char* V_lds = lds; char* K_lds = lds + 32768;
  float* wsl = reinterpret_cast<float*>(lds + LDS_WS) + wid * 64;
  const float nMC = -WS{P.ws}.consts()[layer * 1024 + 2];
  bf16x8 qr[12];
  {
    const u16* Qw = WS{P.ws}.QB() + (tok0 + qpos) * 768 + head * 192 + hi * 8;
#pragma unroll
    for (int ks = 0; ks < 12; ++ks) qr[ks] = *reinterpret_cast<const bf16x8*>(Qw + ks * 16);
  }
  const u16* Kh = WS{P.ws}.KB() + tok0 * 768 + head * 192;
  const u16* Vh = WS{P.ws}.VB() + tok0 * 512 + head * 128;
  int bkoff[3], bvoff[2], ldst[3];
#pragma unroll
  for (int i = 0; i < 3; ++i) {
    const int p = (wid + 8 * i) * 1024 + lane * 16;
    ldst[i] = p;
    const int row = p / 384, pch = (p - row * 384) >> 4, ch = pch ^ ((row >> 1) & 7);
    bkoff[i] = row * 768 + ch * 8;
    if (i < 2) {
      const int st = p >> 9, within = p & 511, kk = (st >> 2) * 8 + (within >> 6);
      const int k = kk, col = (st & 3) * 32 + ((within & 63) >> 1);
      bvoff[i] = k * 512 + col;
    }
  }
  const int vb0 = (int)(uintptr_t)V_lds + v_rd_base(lane);
  const int kq = r32 * 384, ksw = (r32 >> 1) & 7;
#define BLOAD(b, k0) do { _Pragma("unroll") for (int i = 0; i < 3; ++i) glds16(Kh + (long)(k0) * 768 + bkoff[i], K_lds + (b) * 24576 + ldst[i]); \
    _Pragma("unroll") for (int i = 0; i < 2; ++i) glds16(Vh + (long)(k0) * 512 + bvoff[i], V_lds + (b) * 16384 + ldst[i]); } while (0)
  f32x16 o[4] = {f32x16{}, f32x16{}, f32x16{}, f32x16{}};
  float lsum = 0.f;
  const int NT = seqlen >> 6;
  BLOAD(0, 0); asm volatile("s_waitcnt vmcnt(0)" ::: "memory"); __syncthreads();
  for (int j = 0; j < NT; ++j) {
    if (j + 1 < NT) BLOAD((j + 1) & 1, (j + 1) * 64);
    const char* Ks = K_lds + (j & 1) * 24576;
    const int vb = vb0 + (j & 1) * 16384;
    f32x16 p0, p1;
#pragma unroll
    for (int r = 0; r < 16; ++r) { p0[r] = nMC; p1[r] = nMC; }
    bf16x8 pa0, pa1, pa2, pa3;
    s16x4 fa[8], fb[8];
    {
      bf16x8 kf[12];
#pragma unroll
      for (int ks = 0; ks < 12; ++ks) kf[ks] = *reinterpret_cast<const bf16x8*>(Ks + kq + (((ks * 2 + hi) ^ ksw) << 4));
#pragma unroll
      for (int ks = 0; ks < 12; ++ks) p0 = __builtin_amdgcn_mfma_f32_32x32x16_bf16(kf[ks], qr[ks], p0, 0, 0, 0);
      SGB(0x100, 4); SGB(0x008, 2); SGB(0x100, 2); SGB(0x008, 2); SGB(0x100, 2); SGB(0x008, 2); SGB(0x100, 2); SGB(0x008, 2); SGB(0x100, 2); SGB(0x008, 4);
    }
    SBAR();
    {
      trq<0, 0>(vb, fa);
      bf16x8 kf[12];
#pragma unroll
      for (int ks = 0; ks < 12; ++ks) kf[ks] = *reinterpret_cast<const bf16x8*>(Ks + kq + 32 * 384 + (((ks * 2 + hi) ^ ksw) << 4));
#pragma unroll
      for (int ks = 0; ks < 12; ++ks) p1 = __builtin_amdgcn_mfma_f32_32x32x16_bf16(kf[ks], qr[ks], p1, 0, 0, 0);
      sm_exp(p0, lsum); sm_pack(p0, pa0, pa1);
    }
    asm volatile("s_waitcnt lgkmcnt(0)" ::: "memory"); SBAR();
    trq<0, 2>(vb, fb);
    mmaq(o[0], o[1], fa, pa0, pa1);
    sm_exp(p1, lsum);
    asm volatile("s_waitcnt lgkmcnt(0)" ::: "memory"); SBAR();
    trq<2, 0>(vb, fa);
    mmaq(o[2], o[3], fb, pa0, pa1);
    sm_pack(p1, pa2, pa3);
    asm volatile("s_waitcnt lgkmcnt(0)" ::: "memory"); SBAR();
    trq<2, 2>(vb, fb);
    mmaq(o[0], o[1], fa, pa2, pa3);
    asm volatile("s_waitcnt lgkmcnt(0)" ::: "memory"); SBAR();
    mmaq(o[2], o[3], fb, pa2, pa3);
    asm volatile("s_waitcnt vmcnt(0)" ::: "memory");
    __syncthreads();
  }
#undef BLOAD
  lsum = swapsum(lsum);
  if (hi == 0) wsl[r32] = 1.f / lsum;
  asm volatile("s_waitcnt lgkmcnt(0)" ::: "memory");
  u16* gp = WS{P.ws}.G() + (tok0 + qb * 256 + wid * 32) * 1024 + 512 + head * 128 + r32;
#pragma unroll
  for (int r = 0; r < 16; ++r) {
    const int row = crow(r, hi);
    const float rl = wsl[row];
#pragma unroll
    for (int d0 = 0; d0 < 4; ++d0) {
      u16* p = gp + (long)row * 1024 + d0 * 32;
      const float y = o[d0][r] * rl * bf2f(*p);
      *p = (u16)(cvtpk(y, 0.f) & 0xffffu);
    }
  }
  __syncthreads();
}

DEV void phase_inproj(const Params& P, int layer, int batch, char* lds) {
  PgOrder S; S.init(TB, NPAD, opaque_nb(), opaque_bid());
  PG_LAS float* rl = (PG_LAS float*)(lds + 131072);
  {
    const int tid = opaque_tid();
#pragma unroll 1
    for (int i0 = 0; i0 < 8; i0 += 2) {
      const int i = i0 + (tid >> 8); PgUnit u;
      if (S.next(i, u)) {
        const int t = u.pm * 256 + (tid & 255);
        float ss = 0.f;
#pragma unroll
        for (int j = 0; j < 16; ++j) ss += WS{P.ws}.ssq_x()[((long)batch * 16 + j) * TB + t];
        rl[i * 256 + (tid & 255)] = __builtin_amdgcn_rsqf(ss * (1.f / 1024.f) + EPS);
      }
    }
    __syncthreads();
  }
  PgEpiIn E{&P, layer, batch, rl};
  pg_gemm_phase((PG_LAS unsigned char*)lds, WS{P.ws}.XB() + (long)batch * TB * DM, WS{P.ws}.WinT() + (long)layer * NPAD * DM, TB, NPAD, 1024, S, E);
}
DEV void phase_up(const Params& P, int layer, int batch, char* lds) {
  for (int tile = opaque_bid(), nb_ = opaque_nb(); tile < 512; tile += nb_) {
    const int kind = tile >> 8, rem = tile & 255, head = rem & 3, mt = rem >> 2;
    if (kind == 0) gemm_tile<8, 1, 256, EPI_UKV>(WS{P.ws}.CKV(), 128, WS{P.ws}.WukvT() + ((long)layer * 1024 + head * 256) * 128, 128, 128, mt * 256, lds, P, layer, batch, head);
    else           gemm_tile<8, 1, 192, EPI_UQ>(WS{P.ws}.CQ(), 256, WS{P.ws}.WuqT() + ((long)layer * 768 + head * 192) * 256, 256, 256, mt * 256, lds, P, layer, batch, head);
  }
}
DEV void phase_attn(const Params& P, int layer, int batch, char* lds) {
  unsigned* ctr = reinterpret_cast<unsigned*>(P.ws + O_CONST + 8192 - 512) + (batch * 2 + layer) * 16;
  volatile int* qw = reinterpret_cast<volatile int*>(lds + LDS_WS + 2048 - 16);
  for (;;) {
    if (threadIdx.x == 0) *qw = (int)__hip_atomic_fetch_add(ctr, 1u, __ATOMIC_RELAXED, __HIP_MEMORY_SCOPE_AGENT);
    __syncthreads();
    const int it = __builtin_amdgcn_readfirstlane(*qw);
    __syncthreads();
    if (it >= 768) break;
    if (it < 256) attn_b_item(P, layer, batch, it, lds);
    else          attn_a_item(P, layer, batch, it - 256, lds);
  }
}
DEV void phase_outproj(const Params& P, int layer, int batch, char* lds) {
  PgOrder S; S.init(TB, 1024, opaque_nb(), opaque_bid());
  PgEpiOut E{&P, layer, batch};
  pg_gemm_phase((PG_LAS unsigned char*)lds, WS{P.ws}.G(), WS{P.ws}.WoutT() + (long)layer * 1024 * DM, TB, 1024, 1024, S, E);
}

DEV void grid_bar(unsigned* ctr, unsigned target) {
  asm volatile("s_waitcnt vmcnt(0)" ::: "memory");
  __syncthreads();
  if (threadIdx.x == 0) {
    __builtin_amdgcn_fence(__ATOMIC_RELEASE, "agent");
    asm volatile("s_waitcnt vmcnt(0)" ::: "memory");
    __hip_atomic_fetch_add(ctr, 1u, __ATOMIC_RELAXED, __HIP_MEMORY_SCOPE_AGENT);
    while (__hip_atomic_load(ctr, __ATOMIC_RELAXED, __HIP_MEMORY_SCOPE_AGENT) < target) __builtin_amdgcn_s_sleep(1);
    __builtin_amdgcn_fence(__ATOMIC_ACQUIRE, "agent");
    asm volatile("s_waitcnt vmcnt(0)" ::: "memory");
  }
  __syncthreads();
}

__global__ __launch_bounds__(NTHR, 1) void hymba_mega(Params P) {
  extern __shared__ __attribute__((aligned(16))) char lds[];
  cg::grid_group grid = cg::this_grid();
  unsigned* bctr = reinterpret_cast<unsigned*>(P.ws + O_CONST + 8192 - 256);
  if (blockIdx.x == 0 && threadIdx.x == 0) *bctr = 0u;
  if (blockIdx.x == 0 && threadIdx.x < 64) reinterpret_cast<unsigned*>(P.ws + O_CONST + 8192 - 512)[threadIdx.x] = 0u;
  phase_prologue(P, lds);
  grid.sync();
  unsigned nbar = 0;
  for (int batch = 0; batch < 2; ++batch) {
    for (int layer = 0; layer < 2; ++layer) {
      Params Q = P;
#define LAUNDER() do { char* w_ = P.ws; float* o_ = P.out; asm volatile("" : "+s"(w_), "+s"(o_)); Q.ws = w_; Q.out = o_; } while (0)
#define GBAR() do { ++nbar; grid_bar(reinterpret_cast<unsigned*>(Q.ws + O_CONST + 8192 - 256), nbar * gridDim.x); } while (0)
      LAUNDER(); phase_inproj(Q, layer, batch, lds);
      GBAR();
      LAUNDER(); phase_up(Q, layer, batch, lds);
      GBAR();
      LAUNDER(); phase_attn(Q, layer, batch, lds);
      GBAR();
      LAUNDER(); phase_outproj(Q, layer, batch, lds);
      if (!(batch == 1 && layer == 1)) GBAR();
#undef LAUNDER
#undef GBAR
    }
  }
}

extern "C" void kernel_launch(void* const* d_in, const int* in_sizes, int n_in, void* d_out, int out_size, void* d_ws, size_t ws_size, hipStream_t stream) {
  static int grid_blocks = 0;
  if (grid_blocks == 0) {
    int dev = 0, cus = 0, per_cu = 0;
    (void)hipGetDevice(&dev);
    (void)hipDeviceGetAttribute(&cus, hipDeviceAttributeMultiprocessorCount, dev);
    if (hipFuncSetAttribute((const void*)hymba_mega, hipFuncAttributeMaxDynamicSharedMemorySize, LDS_BYTES) != hipSuccess) { fprintf(stderr, "hipFuncSetAttribute failed\n"); grid_blocks = -1; return; }
    if (hipOccupancyMaxActiveBlocksPerMultiprocessor(&per_cu, (const void*)hymba_mega, NTHR, LDS_BYTES) != hipSuccess || per_cu < 1) { fprintf(stderr, "occupancy query: %d\n", per_cu); per_cu = 1; }
    (void)hipGetLastError();
    grid_blocks = cus * per_cu;
  }
  if (grid_blocks < 0) return;
  Params p{};
  p.xin0 = (const float*)d_in[0]; p.xin1 = (const float*)d_in[1];
  p.norm_w = (const float*)d_in[2]; p.w_in = (const float*)d_in[3]; p.a_q_norm = (const float*)d_in[4]; p.a_k_norm = (const float*)d_in[5];
  p.a_lq1 = (const float*)d_in[6]; p.a_lk1 = (const float*)d_in[7]; p.a_lq2 = (const float*)d_in[8]; p.a_lk2 = (const float*)d_in[9];
  p.a_subln = (const float*)d_in[10]; p.b_cq_norm = (const float*)d_in[11]; p.b_w_uq = (const float*)d_in[12]; p.b_ckv_norm = (const float*)d_in[13];
  p.b_w_ukv = (const float*)d_in[14]; p.b_q_norm = (const float*)d_in[15]; p.b_k_norm = (const float*)d_in[16]; p.w_out = (const float*)d_in[17];
  p.out = (float*)d_out;
  p.ws = (char*)d_ws;
  if (WS_END > ws_size) { fprintf(stderr, "workspace too small: need %zu have %zu\n", (size_t)WS_END, ws_size); return; }
  void* args[] = {&p};
  hipError_t e = hipLaunchCooperativeKernel((const void*)hymba_mega, dim3(grid_blocks), dim3(NTHR), args, LDS_BYTES, stream);
  if (e != hipSuccess) fprintf(stderr, "cooperative launch failed: %s (grid %d)\n", hipGetErrorString(e), grid_blocks);
}
```

```cpp
#include <hip/hip_runtime.h>
#include <hip/hip_cooperative_groups.h>
#include <cstdio>
#include <cstdint>
namespace cg = cooperative_groups;

typedef unsigned short u16;
using bf16x8 = __attribute__((ext_vector_type(8))) short;
using s16x4  = __attribute__((ext_vector_type(4))) short;
using f32x16 = __attribute__((ext_vector_type(16))) float;
using f32x4  = __attribute__((ext_vector_type(4))) float;
using u32x4  = __attribute__((ext_vector_type(4))) unsigned;
using u32x2  = __attribute__((ext_vector_type(2))) unsigned;
#define DEV __device__ __forceinline__
#define SBAR() __builtin_amdgcn_sched_barrier(0)

constexpr int TB = 16384, DM = 1024, NPAD = 3072, INC = 3008, NTHR = 512;
constexpr float EPS = 1e-6f, LOG2E = 1.4426950408889634f;
constexpr int LDS_BYTES = 139264;
constexpr int LDS_WS = 131072;

struct Params {
  const float* xin0; const float* xin1;
  const float* norm_w; const float* w_in; const float* a_q_norm; const float* a_k_norm;
  const float* a_lq1; const float* a_lk1; const float* a_lq2; const float* a_lk2;
  const float* a_subln; const float* b_cq_norm; const float* b_w_uq; const float* b_ckv_norm;
  const float* b_w_ukv; const float* b_q_norm; const float* b_k_norm; const float* w_out;
  float* out;
  char* ws;
};
constexpr size_t al256(size_t x) { return (x + 255) & ~(size_t)255; }
constexpr size_t O_XB = 0;
constexpr size_t O_QA = O_XB + al256((size_t)2 * TB * DM * 2);
constexpr size_t O_KA = O_QA + al256((size_t)TB * 512 * 2);
constexpr size_t O_VA = O_KA + al256((size_t)TB * 512 * 2);
constexpr size_t O_G = O_VA + al256((size_t)TB * 512 * 2);
constexpr size_t O_CQ = O_G + al256((size_t)TB * 1024 * 2);
constexpr size_t O_CKV = O_CQ + al256((size_t)TB * 256 * 2);
constexpr size_t O_KR = O_CKV + al256((size_t)TB * 128 * 2);
constexpr size_t O_QB = O_KR + al256((size_t)TB * 64 * 4);
constexpr size_t O_KB = O_QB + al256((size_t)TB * 768 * 2);
constexpr size_t O_VB = O_KB + al256((size_t)TB * 768 * 2);
constexpr size_t O_SSQX = O_VB + al256((size_t)TB * 512 * 2);
constexpr size_t O_SSQCQ = O_SSQX + al256((size_t)2 * 16 * TB * 4);
constexpr size_t O_SSQCKV = O_SSQCQ + al256((size_t)4 * TB * 4);
constexpr size_t O_WIN = O_SSQCKV + al256((size_t)2 * TB * 4);
constexpr size_t O_WOUT = O_WIN + al256((size_t)2 * NPAD * DM * 2);
constexpr size_t O_WUQ = O_WOUT + al256((size_t)2 * 1024 * DM * 2);
constexpr size_t O_WUKV = O_WUQ + al256((size_t)2 * 768 * 256 * 2);
constexpr size_t O_ROPE = O_WUKV + al256((size_t)2 * 1024 * 128 * 2);
constexpr size_t O_CONST = O_ROPE + al256((size_t)16384 * 32 * 8);
constexpr size_t WS_END = O_CONST + 8192;
struct WS {
  char* b;
  DEV u16* XB() const { return (u16*)(b + O_XB); }   DEV u16* QA() const { return (u16*)(b + O_QA); }
  DEV u16* KA() const { return (u16*)(b + O_KA); }   DEV u16* VA() const { return (u16*)(b + O_VA); }
  DEV u16* G() const { return (u16*)(b + O_G); }     DEV u16* CQ() const { return (u16*)(b + O_CQ); }
  DEV u16* CKV() const { return (u16*)(b + O_CKV); } DEV float* KR() const { return (float*)(b + O_KR); }
  DEV u16* QB() const { return (u16*)(b + O_QB); }   DEV u16* KB() const { return (u16*)(b + O_KB); }
  DEV u16* VB() const { return (u16*)(b + O_VB); }
  DEV float* ssq_x() const { return (float*)(b + O_SSQX); } DEV float* ssq_cq() const { return (float*)(b + O_SSQCQ); }
  DEV float* ssq_ckv() const { return (float*)(b + O_SSQCKV); }
  DEV u16* WinT() const { return (u16*)(b + O_WIN); } DEV u16* WoutT() const { return (u16*)(b + O_WOUT); }
  DEV u16* WuqT() const { return (u16*)(b + O_WUQ); } DEV u16* WukvT() const { return (u16*)(b + O_WUKV); }
  DEV float2* rope() const { return (float2*)(b + O_ROPE); } DEV float* consts() const { return (float*)(b + O_CONST); }
};

DEV int opaque_tid() { int t = threadIdx.x; asm volatile("" : "+v"(t)); return t; }
DEV int opaque_bid() { int b = blockIdx.x; asm volatile("" : "+s"(b)); return b; }
DEV int opaque_nb() { int b = gridDim.x; asm volatile("" : "+s"(b)); return b; }
DEV int crow(int r, int hi) { return (r & 3) + 8 * (r >> 2) + 4 * hi; }
DEV unsigned cvtpk(float lo, float hi) {
  unsigned r; asm volatile("v_cvt_pk_bf16_f32 %0, %1, %2" : "=v"(r) : "v"(lo), "v"(hi)); return r;
}
DEV float swapsum(float v) {
  auto rr = __builtin_amdgcn_permlane32_swap(__float_as_uint(v), __float_as_uint(v), false, false);
  return __uint_as_float(rr[0]) + __uint_as_float(rr[1]);
}
#define SWZ_XOR(v, k) __int_as_float(__builtin_amdgcn_ds_swizzle(__float_as_int(v), ((k) << 10) | 0x1F))
DEV float siluf(float x) { return x * __builtin_amdgcn_rcpf(1.f + __builtin_amdgcn_exp2f(-LOG2E * x)); }
DEV float bf2f(u16 v) { return __uint_as_float(((unsigned)v) << 16); }

DEV void store8bf(u16* dst, const float* v) {
  u32x4 w = {cvtpk(v[0], v[1]), cvtpk(v[2], v[3]), cvtpk(v[4], v[5]), cvtpk(v[6], v[7])};
  *reinterpret_cast<u32x4*>(dst) = w;
}

DEV void cvt_transpose_tiles(const float* __restrict__ src, const float* __restrict__ scale, u16* __restrict__ dst, int L, int Kd, int Nsrc, int Ndst, int padlo, int padhi, char* lds, int tid) {
  const int kt = Kd >> 6, ntl = Ndst >> 6, total = L * kt * ntl;
  u16* T = reinterpret_cast<u16*>(lds);
  const int kk = tid >> 3, n8 = (tid & 7) * 8;
  for (int tile = blockIdx.x; tile < total; tile += gridDim.x) {
    const int l = tile / (kt * ntl), r = tile - l * (kt * ntl), kb = r / ntl, nb = r - kb * ntl;
    const int n0 = nb * 64, k0 = kb * 64;
    const int col0 = n0 < padlo ? n0 : (n0 < padhi ? -1 : n0 - (padhi - padlo));
    float v[8];
    if (col0 >= 0) {
      const float* s = src + ((long)l * Kd + k0 + kk) * Nsrc + col0 + n8;
      const float4 a = *reinterpret_cast<const float4*>(s), b = *reinterpret_cast<const float4*>(s + 4);
      const float sc = scale ? scale[l * Kd + k0 + kk] : 1.f;
      v[0] = a.x * sc; v[1] = a.y * sc; v[2] = a.z * sc; v[3] = a.w * sc; v[4] = b.x * sc; v[5] = b.y * sc; v[6] = b.z * sc; v[7] = b.w * sc;
    } else {
#pragma unroll
      for (int j = 0; j < 8; ++j) v[j] = 0.f;
    }
#pragma unroll
    for (int j = 0; j < 8; j += 2) { const unsigned w = cvtpk(v[j], v[j + 1]); T[(n8 + j) * 72 + kk] = (u16)(w & 0xffffu); T[(n8 + j + 1) * 72 + kk] = (u16)(w >> 16); }
    __syncthreads();
    {
      const int nn = tid >> 3, k8 = (tid & 7) * 8;
      const u32x4 o = *reinterpret_cast<const u32x4*>(T + nn * 72 + k8);
      *reinterpret_cast<u32x4*>(dst + ((long)l * Ndst + n0 + nn) * Kd + k0 + k8) = o;
    }
    __syncthreads();
  }
}

DEV void phase_prologue(const Params& P, char* lds) {
  const int tid = opaque_tid(), lane = tid & 63, wid = tid >> 6;
  const int gw = blockIdx.x * 8 + wid, nw = gridDim.x * 8;
  for (int row0 = gw * 4; row0 < 2 * TB; row0 += nw * 4) {
    float4 v[4][4];
#pragma unroll
    for (int q = 0; q < 4; ++q) {
      const int row = row0 + q, b = row >> 14, t = row & (TB - 1);
      const float* x = (b ? P.xin1 : P.xin0) + (long)t * DM;
#pragma unroll
      for (int i = 0; i < 4; ++i) v[q][i] = *reinterpret_cast<const float4*>(x + i * 256 + lane * 4);
    }
#pragma unroll
    for (int q = 0; q < 4; ++q) {
      const int row = row0 + q, b = row >> 14, t = row & (TB - 1);
      u16* xb = WS{P.ws}.XB() + (long)row * DM;
      float ss = 0.f;
#pragma unroll
      for (int i = 0; i < 4; ++i) {
        ss += v[q][i].x * v[q][i].x + v[q][i].y * v[q][i].y + v[q][i].z * v[q][i].z + v[q][i].w * v[q][i].w;
        u32x2 o = {cvtpk(v[q][i].x, v[q][i].y), cvtpk(v[q][i].z, v[q][i].w)};
        *reinterpret_cast<u32x2*>(xb + i * 256 + lane * 4) = o;
      }
      ss += SWZ_XOR(ss, 1); ss += SWZ_XOR(ss, 2); ss += SWZ_XOR(ss, 4); ss += SWZ_XOR(ss, 8); ss += SWZ_XOR(ss, 16); ss = swapsum(ss);
      if (lane < 16) WS{P.ws}.ssq_x()[((long)b * 16 + lane) * TB + t] = (lane == 0) ? ss : 0.f;
    }
  }
  const long gt = (long)blockIdx.x * NTHR + tid, nth = (long)gridDim.x * NTHR;
  cvt_transpose_tiles(P.w_in, P.norm_w, WS{P.ws}.WinT(), 2, 1024, INC, NPAD, 2496, 2560, lds, tid);
  cvt_transpose_tiles(P.w_out, nullptr, WS{P.ws}.WoutT(), 2, 1024, 1024, 1024, 1 << 30, 1 << 30, lds, tid);
  cvt_transpose_tiles(P.b_w_uq, P.b_cq_norm, WS{P.ws}.WuqT(), 2, 256, 768, 768, 1 << 30, 1 << 30, lds, tid);
  cvt_transpose_tiles(P.b_w_ukv, P.b_ckv_norm, WS{P.ws}.WukvT(), 2, 128, 1024, 1024, 1 << 30, 1 << 30, lds, tid);
  for (long u = gt; u < 16384L * 32; u += nth) {
    const int pos = (int)(u >> 5), i = (int)(u & 31);
    const double inv = exp2(-(double)i * (13.287712379549449 / 32.0));
    const float ang = (float)pos * (float)inv;
    const double a = (double)ang;
    const double n = rint(a * 0.15915494309189535);
    double r = fma(-n, 6.283185307179586, a);
    r = fma(-n, 2.4492935982947064e-16, r);
    const double r2 = r * r;
    double sn = r, cs = 1.0, ts = r, tc = 1.0;
#pragma unroll
    for (int k = 1; k <= 16; ++k) {
      tc = -tc * r2 * (1.0 / (double)((2 * k - 1) * (2 * k)));
      ts = -ts * r2 * (1.0 / (double)((2 * k) * (2 * k + 1)));
      cs += tc; sn += ts;
    }
    WS{P.ws}.rope()[u] = make_float2((float)cs, (float)sn);
  }
  if (blockIdx.x == 1) {
    float* cst = WS{P.ws}.consts();
    for (int l = 0; l < 2; ++l) {
      if (tid < 64) { cst[l * 1024 + 64 + tid] = P.a_q_norm[l * 64 + tid]; cst[l * 1024 + 128 + tid] = P.a_k_norm[l * 64 + tid]; }
      if (tid < 128) cst[l * 1024 + 192 + tid] = P.a_subln[l * 128 + tid];
      if (tid < 192) { cst[l * 1024 + 320 + tid] = P.b_q_norm[l * 192 + tid]; cst[l * 1024 + 512 + tid] = P.b_k_norm[l * 192 + tid]; }
    }
  }
  if (blockIdx.x == 0 && tid < 2) {
    const int l = tid;
    float d1 = 0.f, d2 = 0.f, gq = 0.f, gk = 0.f, bq = 0.f, bk = 0.f;
    for (int i = 0; i < 64; ++i) {
      d1 += P.a_lq1[l * 64 + i] * P.a_lk1[l * 64 + i];
      d2 += P.a_lq2[l * 64 + i] * P.a_lk2[l * 64 + i];
      gq = fmaxf(gq, fabsf(P.a_q_norm[l * 64 + i])); gk = fmaxf(gk, fabsf(P.a_k_norm[l * 64 + i]));
    }
    for (int i = 0; i < 192; ++i) { bq = fmaxf(bq, fabsf(P.b_q_norm[l * 192 + i])); bk = fmaxf(bk, fabsf(P.b_k_norm[l * 192 + i])); }
    const float lam_init = l == 0 ? 0.2f : 0.35550907f;
    WS{P.ws}.consts()[l * 1024 + 0] = expf(d1) - expf(d2) + lam_init;
    WS{P.ws}.consts()[l * 1024 + 1] = 8.f * gq * gk * LOG2E;
    WS{P.ws}.consts()[l * 1024 + 2] = 13.856406460551018f * bq * bk * LOG2E;
    WS{P.ws}.consts()[l * 1024 + 3] = lam_init;
  }
}

DEV void glds16(const u16* g, char* l) { __builtin_amdgcn_global_load_lds((const unsigned*)g, (unsigned*)l, 16, 0, 0); }
DEV int swz128(int row, int chunk) { return row * 128 + ((chunk ^ ((row >> 1) & 7)) << 4); }

enum { EPI_IN = 0, EPI_UQ = 1, EPI_UKV = 2, EPI_OUT = 3 };

template <int MI, int NI> struct Acc { f32x16 a[MI][NI]; };

DEV void st4bf(u16* dst, float a, float b, float c, float d) {
  u32x2 o = {cvtpk(a, b), cvtpk(c, d)};
  *reinterpret_cast<u32x2*>(dst) = o;
}

#define LDSP(T) __attribute__((address_space(3))) T*
DEV void st4lds(char* rowbase, int col, float a, float b, float c, float d) {
  u32x2 o = {cvtpk(a, b), cvtpk(c, d)};
  *(LDSP(u32x2))(rowbase + col * 2) = o;
}
template <int NCH, int STRIDE> DEV void slab_flush(char* slab, u16* grow0, int gstride, int lane) {
  asm volatile("s_waitcnt lgkmcnt(0)" ::: "memory");
#pragma unroll
  for (int i = 0; i < NCH / 2; ++i) {
    const int q = i * 64 + lane, row = q / NCH, cc = q - row * NCH;
    const u32x4 v = *(LDSP(const u32x4))(slab + row * STRIDE + cc * 16);
    *reinterpret_cast<u32x4*>(grow0 + (long)row * gstride + cc * 8) = v;
  }
  asm volatile("s_waitcnt lgkmcnt(0)" ::: "memory");
}

DEV void epi_inproj(f32x16 (&acc)[2][4], const Params& P, int layer, int batch, int m0, int nt, int wm, int wn, int r32, int hi, char* lds) {
  char* slab = lds + (wm * 2 + wn) * 8704; char* dst = slab + r32 * 272;
  const int lane = hi * 32 + r32;
#pragma unroll
  for (int mi = 0; mi < 2; ++mi) {
    const int t = m0 + wm * 64 + mi * 32 + r32;
    const long t0 = m0 + wm * 64 + mi * 32;
    u16* gdst; int gstr;
    float ss = 0.f;
#pragma unroll
    for (int j = 0; j < 8; ++j) ss += WS{P.ws}.ssq_x()[((long)batch * 8 + j) * TB + t];
    const float rstd = __builtin_amdgcn_rsqf(ss * (1.f / 1024.f) + EPS);
#pragma unroll
    for (int ni = 0; ni < 4; ++ni)
#pragma unroll
      for (int r = 0; r < 16; ++r) acc[mi][ni][r] *= rstd;
    if (nt < 4) {
      const float* g = WS{P.ws}.consts() + layer * 1024 + (nt < 2 ? 64 : 128);
      const float sc = nt < 2 ? 0.125f * LOG2E : 1.f;
      gdst = (nt < 2 ? WS{P.ws}.QA() : WS{P.ws}.KA()) + t0 * 512 + (nt & 1) * 256 + wn * 128; gstr = 512;
#pragma unroll
      for (int grp = 0; grp < 2; ++grp) {
        float s = 0.f;
#pragma unroll
        for (int b = 0; b < 2; ++b)
#pragma unroll
          for (int r = 0; r < 16; ++r) s += acc[mi][grp * 2 + b][r] * acc[mi][grp * 2 + b][r];
        s = swapsum(s);
        const float inv = __builtin_amdgcn_rsqf(s * (1.f / 64.f) + EPS) * sc;
#pragma unroll
        for (int b = 0; b < 2; ++b)
#pragma unroll
          for (int r4 = 0; r4 < 4; ++r4) {
            const int c = b * 32 + r4 * 8 + hi * 4;
            const float4 gg = *reinterpret_cast<const float4*>(g + c);
            const f32x16& a = acc[mi][grp * 2 + b];
            st4lds(dst, grp * 64 + c, a[r4 * 4] * inv * gg.x, a[r4 * 4 + 1] * inv * gg.y, a[r4 * 4 + 2] * inv * gg.z, a[r4 * 4 + 3] * inv * gg.w);
          }
      }
    } else if (nt < 6) {
      gdst = WS{P.ws}.VA() + t0 * 512 + (nt & 1) * 256 + wn * 128; gstr = 512;
#pragma unroll
      for (int ni = 0; ni < 4; ++ni)
#pragma unroll
        for (int r4 = 0; r4 < 4; ++r4) {
          const f32x16& a = acc[mi][ni];
          st4lds(dst, ni * 32 + r4 * 8 + hi * 4, a[r4 * 4], a[r4 * 4 + 1], a[r4 * 4 + 2], a[r4 * 4 + 3]);
        }
    } else if (nt < 8 || nt >= 10) {
      gdst = WS{P.ws}.G() + t0 * 1024 + (nt >= 10 ? 512 + (nt - 10) * 256 : (nt - 6) * 256) + wn * 128; gstr = 1024;
#pragma unroll
      for (int ni = 0; ni < 4; ++ni)
#pragma unroll
        for (int r4 = 0; r4 < 4; ++r4) {
          const f32x16& a = acc[mi][ni];
          st4lds(dst, ni * 32 + r4 * 8 + hi * 4, siluf(a[r4 * 4]), siluf(a[r4 * 4 + 1]), siluf(a[r4 * 4 + 2]), siluf(a[r4 * 4 + 3]));
        }
    } else if (nt == 8) {
      gdst = WS{P.ws}.CQ() + t0 * 256 + wn * 128; gstr = 256;
      float s = 0.f;
#pragma unroll
      for (int ni = 0; ni < 4; ++ni) {
        const f32x16& a = acc[mi][ni];
#pragma unroll
        for (int r = 0; r < 16; ++r) s += a[r] * a[r];
#pragma unroll
        for (int r4 = 0; r4 < 4; ++r4) st4lds(dst, ni * 32 + r4 * 8 + hi * 4, a[r4 * 4], a[r4 * 4 + 1], a[r4 * 4 + 2], a[r4 * 4 + 3]);
      }
      s = swapsum(s);
      if (hi == 0) WS{P.ws}.ssq_cq()[(long)wn * TB + t] = s;
    } else {
      if (wn == 0) {
        gdst = WS{P.ws}.CKV() + t0 * 128; gstr = 128;
        float s = 0.f;
#pragma unroll
        for (int ni = 0; ni < 4; ++ni) {
          const f32x16& a = acc[mi][ni];
#pragma unroll
          for (int r = 0; r < 16; ++r) s += a[r] * a[r];
#pragma unroll
          for (int r4 = 0; r4 < 4; ++r4) st4lds(dst, ni * 32 + r4 * 8 + hi * 4, a[r4 * 4], a[r4 * 4 + 1], a[r4 * 4 + 2], a[r4 * 4 + 3]);
        }
        s = swapsum(s);
        if (hi == 0) WS{P.ws}.ssq_ckv()[t] = s;
      } else {
        gdst = reinterpret_cast<u16*>(WS{P.ws}.KR() + t0 * 64); gstr = 128;
#pragma unroll
        for (int ni = 0; ni < 2; ++ni)
#pragma unroll
          for (int r4 = 0; r4 < 4; ++r4) {
            const f32x16& a = acc[mi][ni];
            *(LDSP(f32x4))(dst + (ni * 32 + r4 * 8 + hi * 4) * 4) = f32x4{a[r4 * 4], a[r4 * 4 + 1], a[r4 * 4 + 2], a[r4 * 4 + 3]};
          }
      }
    }
    slab_flush<16, 272>(slab, gdst, gstr, lane);
  }
}

DEV void epi_uq(f32x16 (&acc)[1][6], const Params& P, int layer, int batch, int m0, int head, int wid, int r32, int hi, char* lds) {
  const int t = m0 + wid * 32 + r32;
  const float rc = __builtin_amdgcn_rsqf((WS{P.ws}.ssq_cq()[t] + WS{P.ws}.ssq_cq()[TB + t] + WS{P.ws}.ssq_cq()[2 * TB + t] + WS{P.ws}.ssq_cq()[3 * TB + t]) * (1.f / 256.f) + EPS);
  float s = 0.f;
#pragma unroll
  for (int ni = 0; ni < 6; ++ni)
#pragma unroll
    for (int r = 0; r < 16; ++r) { acc[0][ni][r] *= rc; s += acc[0][ni][r] * acc[0][ni][r]; }
  s = swapsum(s);
  constexpr float SCQ = 0.07216878364870323f * LOG2E;
  const float inv = __builtin_amdgcn_rsqf(s * (1.f / 192.f) + EPS) * SCQ;
  const float* g = WS{P.ws}.consts() + layer * 1024 + 320;
  char* slab = lds + wid * 12800; char* dst = slab + r32 * 400;
#pragma unroll
  for (int ni = 0; ni < 4; ++ni)
#pragma unroll
    for (int r4 = 0; r4 < 4; ++r4) {
      const int c = ni * 32 + r4 * 8 + hi * 4;
      const float4 gg = *reinterpret_cast<const float4*>(g + c);
      const f32x16& a = acc[0][ni];
      st4lds(dst, c, a[r4 * 4] * inv * gg.x, a[r4 * 4 + 1] * inv * gg.y, a[r4 * 4 + 2] * inv * gg.z, a[r4 * 4 + 3] * inv * gg.w);
    }
  const int pos = batch ? t : (t & 4095);
  const float2* rp = WS{P.ws}.rope() + (long)pos * 32;
#pragma unroll
  for (int r4 = 0; r4 < 4; ++r4) {
    const int i = r4 * 8 + hi * 4;
    const float4 g1 = *reinterpret_cast<const float4*>(g + 128 + i), g2 = *reinterpret_cast<const float4*>(g + 160 + i);
    const float4 cs01 = *reinterpret_cast<const float4*>(rp + i), cs23 = *reinterpret_cast<const float4*>(rp + i + 2);
    const float x1[4] = {acc[0][4][r4 * 4] * inv * g1.x, acc[0][4][r4 * 4 + 1] * inv * g1.y, acc[0][4][r4 * 4 + 2] * inv * g1.z, acc[0][4][r4 * 4 + 3] * inv * g1.w};
    const float x2[4] = {acc[0][5][r4 * 4] * inv * g2.x, acc[0][5][r4 * 4 + 1] * inv * g2.y, acc[0][5][r4 * 4 + 2] * inv * g2.z, acc[0][5][r4 * 4 + 3] * inv * g2.w};
    const float cc[4] = {cs01.x, cs01.z, cs23.x, cs23.z}, sn[4] = {cs01.y, cs01.w, cs23.y, cs23.w};
    st4lds(dst, 128 + i, x1[0] * cc[0] - x2[0] * sn[0], x1[1] * cc[1] - x2[1] * sn[1], x1[2] * cc[2] - x2[2] * sn[2], x1[3] * cc[3] - x2[3] * sn[3]);
    st4lds(dst, 160 + i, x1[0] * sn[0] + x2[0] * cc[0], x1[1] * sn[1] + x2[1] * cc[1], x1[2] * sn[2] + x2[2] * cc[2], x1[3] * sn[3] + x2[3] * cc[3]);
  }
  slab_flush<24, 400>(slab, WS{P.ws}.QB() + (long)(m0 + wid * 32) * 768 + head * 192, 768, hi * 32 + r32);
}

DEV void epi_ukv(f32x16 (&acc)[1][8], const Params& P, int layer, int batch, int m0, int head, int wid, int r32, int hi, char* lds) {
  const int t = m0 + wid * 32 + r32;
  const float rc = __builtin_amdgcn_rsqf((WS{P.ws}.ssq_ckv()[t] + WS{P.ws}.ssq_ckv()[TB + t]) * (1.f / 128.f) + EPS);
  char* slab = lds + wid * 12800; char* vdst = slab + r32 * 272;
#pragma unroll
  for (int ni = 4; ni < 8; ++ni)
#pragma unroll
    for (int r4 = 0; r4 < 4; ++r4) {
      const f32x16& a = acc[0][ni];
      st4lds(vdst, (ni - 4) * 32 + r4 * 8 + hi * 4, a[r4 * 4] * rc, a[r4 * 4 + 1] * rc, a[r4 * 4 + 2] * rc, a[r4 * 4 + 3] * rc);
    }
  slab_flush<16, 272>(slab, WS{P.ws}.VB() + (long)(m0 + wid * 32) * 512 + head * 128, 512, hi * 32 + r32);
  float s = 0.f;
#pragma unroll
  for (int ni = 0; ni < 4; ++ni)
#pragma unroll
    for (int r = 0; r < 16; ++r) { acc[0][ni][r] *= rc; s += acc[0][ni][r] * acc[0][ni][r]; }
  float4 kr[2][4];
#pragma unroll
  for (int b = 0; b < 2; ++b)
#pragma unroll
    for (int r4 = 0; r4 < 4; ++r4) {
      kr[b][r4] = *reinterpret_cast<const float4*>(WS{P.ws}.KR() + (long)t * 64 + b * 32 + r4 * 8 + hi * 4);
      s += kr[b][r4].x * kr[b][r4].x + kr[b][r4].y * kr[b][r4].y + kr[b][r4].z * kr[b][r4].z + kr[b][r4].w * kr[b][r4].w;
    }
  s = swapsum(s);
  const float inv = __builtin_amdgcn_rsqf(s * (1.f / 192.f) + EPS);
  const float* g = WS{P.ws}.consts() + layer * 1024 + 512;
  char* dst = slab + r32 * 400;
#pragma unroll
  for (int ni = 0; ni < 4; ++ni)
#pragma unroll
    for (int r4 = 0; r4 < 4; ++r4) {
      const int c = ni * 32 + r4 * 8 + hi * 4;
      const float4 gg = *reinterpret_cast<const float4*>(g + c);
      const f32x16& a = acc[0][ni];
      st4lds(dst, c, a[r4 * 4] * inv * gg.x, a[r4 * 4 + 1] * inv * gg.y, a[r4 * 4 + 2] * inv * gg.z, a[r4 * 4 + 3] * inv * gg.w);
    }
  const int pos = batch ? t : (t & 4095);
  const float2* rp = WS{P.ws}.rope() + (long)pos * 32;
#pragma unroll
  for (int r4 = 0; r4 < 4; ++r4) {
    const int i = r4 * 8 + hi * 4;
    const float4 g1 = *reinterpret_cast<const float4*>(g + 128 + i), g2 = *reinterpret_cast<const float4*>(g + 160 + i);
    const float4 cs01 = *reinterpret_cast<const float4*>(rp + i), cs23 = *reinterpret_cast<const float4*>(rp + i + 2);
    const float x1[4] = {kr[0][r4].x * inv * g1.x, kr[0][r4].y * inv * g1.y, kr[0][r4].z * inv * g1.z, kr[0][r4].w * inv * g1.w};
    const float x2[4] = {kr[1][r4].x * inv * g2.x, kr[1][r4].y * inv * g2.y, kr[1][r4].z * inv * g2.z, kr[1][r4].w * inv * g2.w};
    const float cc[4] = {cs01.x, cs01.z, cs23.x, cs23.z}, sn[4] = {cs01.y, cs01.w, cs23.y, cs23.w};
    st4lds(dst, 128 + i, x1[0] * cc[0] - x2[0] * sn[0], x1[1] * cc[1] - x2[1] * sn[1], x1[2] * cc[2] - x2[2] * sn[2], x1[3] * cc[3] - x2[3] * sn[3]);
    st4lds(dst, 160 + i, x1[0] * sn[0] + x2[0] * cc[0], x1[1] * sn[1] + x2[1] * cc[1], x1[2] * sn[2] + x2[2] * cc[2], x1[3] * sn[3] + x2[3] * cc[3]);
  }
  slab_flush<24, 400>(slab, WS{P.ws}.KB() + (long)(m0 + wid * 32) * 768 + head * 192, 768, hi * 32 + r32);
}

DEV void epi_outproj(f32x16 (&acc)[2][4], const Params& P, int layer, int batch, int m0, int nt, int wm, int wn, int r32, int hi, char* lds) {
  const int lane = hi * 32 + r32, wid = wm * 2 + wn;
  float* T = reinterpret_cast<float*>(lds) + wid * (32 * 132);
  const int c = (lane & 31) * 4, n = nt * 256 + wn * 128 + c;
#pragma unroll
  for (int mi = 0; mi < 2; ++mi) {
#pragma unroll
    for (int ni = 0; ni < 4; ++ni)
#pragma unroll
      for (int r4 = 0; r4 < 4; ++r4) {
        const f32x16& a = acc[mi][ni];
        *reinterpret_cast<float4*>(T + r32 * 132 + ni * 32 + r4 * 8 + hi * 4) = make_float4(a[r4 * 4], a[r4 * 4 + 1], a[r4 * 4 + 2], a[r4 * 4 + 3]);
      }
    asm volatile("s_waitcnt lgkmcnt(0)" ::: "memory");
#pragma unroll 4
    for (int i = 0; i < 16; ++i) {
      const int tl = 2 * i + (lane >> 5), t = m0 + wm * 64 + mi * 32 + tl;
      const long tg = (long)batch * TB + t;
      const float4 a = *reinterpret_cast<const float4*>(T + tl * 132 + c);
      const float* xr = layer == 0 ? (batch ? P.xin1 : P.xin0) + (long)t * DM + n : P.out + tg * DM + n;
      const float4 xv = *reinterpret_cast<const float4*>(xr);
      const float4 o = make_float4(xv.x + a.x, xv.y + a.y, xv.z + a.z, xv.w + a.w);
      *reinterpret_cast<float4*>(P.out + tg * DM + n) = o;
      if (layer == 0) {
        st4bf(WS{P.ws}.XB() + tg * DM + n, o.x, o.y, o.z, o.w);
        float s = o.x * o.x + o.y * o.y + o.z * o.z + o.w * o.w;
#define SWZX(k) s += __int_as_float(__builtin_amdgcn_ds_swizzle(__float_as_int(s), ((k) << 10) | 0x1F))
        SWZX(1); SWZX(2); SWZX(4); SWZX(8); SWZX(16);
#undef SWZX
        if ((lane & 31) == 0) WS{P.ws}.ssq_x()[((long)batch * 8 + nt * 2 + wn) * TB + t] = s;
      }
    }
    asm volatile("s_waitcnt lgkmcnt(0)" ::: "memory");
  }
}

template <int WM, int WN, int BN, int EPI>
DEV void gemm_tile(const u16* __restrict__ A, int lda, const u16* __restrict__ Bt, int ldb, int K, int m0, char* lds,
                   const Params& P, int layer, int batch, int nt) {
  constexpr int MI = 256 / WM / 32, NI = BN / WN / 32, NB = BN / 64;
  const int tid = opaque_tid(), wid = tid >> 6, lane = tid & 63, r32 = lane & 31, hi = lane >> 5;
  const int wm = wid / WN, wn = wid % WN;
  char* As = lds; char* Bs = lds + 65536;
  f32x16 acc[MI][NI];
#pragma unroll
  for (int mi = 0; mi < MI; ++mi)
#pragma unroll
    for (int ni = 0; ni < NI; ++ni) acc[mi][ni] = f32x16{};
  const int srow = tid >> 3, sch = (tid & 7) ^ ((srow >> 1) & 7);
  const u16* Ap = A + (long)(m0 + srow) * lda + sch * 8;
  const u16* Bp = Bt + (long)srow * ldb + sch * 8;
  const int soff = tid * 16;
#define GLOAD(kt, buf) do { _Pragma("unroll") for (int i = 0; i < 4; ++i) glds16(Ap + (long)i * 64 * lda + (kt) * 64, As + (buf) * 32768 + soff + i * 8192); \
    _Pragma("unroll") for (int i = 0; i < NB; ++i) glds16(Bp + (long)i * 64 * ldb + (kt) * 64, Bs + (buf) * 32768 + soff + i * 8192); } while (0)
  GLOAD(0, 0); asm volatile("s_waitcnt vmcnt(0)" ::: "memory"); __syncthreads();
  const int nk = K >> 6;
  for (int kt = 0; kt < nk; ++kt) {
    const bool more = kt + 1 < nk;
    const int nb = (kt + 1) & 1;
    const char* as = As + (kt & 1) * 32768; const char* bs = Bs + (kt & 1) * 32768;
#pragma unroll
    for (int ks = 0; ks < 4; ++ks) {
      if (more) { glds16(Ap + (long)ks * 64 * lda + (kt + 1) * 64, As + nb * 32768 + soff + ks * 8192);
                  if (ks < NB) glds16(Bp + (long)ks * 64 * ldb + (kt + 1) * 64, Bs + nb * 32768 + soff + ks * 8192); }
      SBAR();
      bf16x8 xf[MI], wf[NI];
#pragma unroll
      for (int mi = 0; mi < MI; ++mi) xf[mi] = *reinterpret_cast<const bf16x8*>(as + swz128(wm * (MI * 32) + mi * 32 + r32, ks * 2 + hi));
#pragma unroll
      for (int ni = 0; ni < NI; ++ni) wf[ni] = *reinterpret_cast<const bf16x8*>(bs + swz128(wn * (NI * 32) + ni * 32 + r32, ks * 2 + hi));
#pragma unroll
      for (int mi = 0; mi < MI; ++mi)
#pragma unroll
        for (int ni = 0; ni < NI; ++ni) acc[mi][ni] = __builtin_amdgcn_mfma_f32_32x32x16_bf16(wf[ni], xf[mi], acc[mi][ni], 0, 0, 0);
    }
    asm volatile("s_waitcnt vmcnt(0)" ::: "memory");
    __syncthreads();
  }
#undef GLOAD
  if constexpr (EPI == EPI_IN) { epi_inproj(acc, P, layer, batch, m0, nt, wm, wn, r32, hi, lds); __syncthreads(); }
  else if constexpr (EPI == EPI_UQ) { epi_uq(acc, P, layer, batch, m0, nt, wid, r32, hi, lds); __syncthreads(); }
  else if constexpr (EPI == EPI_UKV) { epi_ukv(acc, P, layer, batch, m0, nt, wid, r32, hi, lds); __syncthreads(); }
  else { epi_outproj(acc, P, layer, batch, m0, nt, wm, wn, r32, hi, lds); __syncthreads(); }
}

DEV float red4(float s) { s += SWZ_XOR(s, 16); return swapsum(s); }
#define PG_LAS __attribute__((address_space(3)))
constexpr int PG_HTB = 128 * 64 * 2;
DEV int pg_lds_byte(int r, int c) { const int st = (r >> 4) * 2 + (c >> 5), rr = r & 15, cc = c & 31, ob = rr * 64 + cc * 2; return st * 1024 + (ob ^ (((ob >> 9) & 1) << 5)); }
DEV void pg_stage_rc(int b, int& R, int& C) { const int st = b / 1024, sb = b % 1024, swz = sb ^ (((sb >> 9) & 1) << 5); R = (st >> 1) * 16 + swz / 64; C = (st & 1) * 32 + (swz % 64) / 2; }
DEV int pg_perm32(int rho) { const int n = rho >> 4, i = rho & 15; return 8 * (i >> 2) + 4 * n + (i & 3); }
struct PgUnit { int pm, pn; };
struct PgOrder {
  int nM, nN, nwg, G, c;
  DEV void init(int M, int N, int G_, int c_) { nM = M / 256; nN = N / 256; nwg = nM * nN; G = G_; c = c_; }
  DEV bool next(int i, PgUnit& u) const {
    const long L = (long)i * G + c; if (L >= nwg) return false;
    int wgid = (int)L; { const int q = nwg / 8, r = nwg % 8, xcd = wgid % 8, off = wgid / 8; wgid = (xcd < r ? xcd * (q + 1) : r * (q + 1) + (xcd - r) * q) + off; }
    const int nig = 8 * nN, gid = wgid / nig, fm = gid * 8, gsz = (nM - fm) < 8 ? (nM - fm) : 8;
    u.pm = fm + ((wgid % nig) % gsz); u.pn = (wgid % nig) / gsz; return true;
  }
};

struct PgEpiIn {
  const Params* Pp; int layer, batch; const PG_LAS float* rl;
  DEV void operator()(f32x4 (&acc)[2][2][4][2], const PgUnit& u, int ui, int wr, int wc, int fr, int fq) const {
    const Params& P = *Pp; const int nt = u.pn;
    const float* g = WS{P.ws}.consts() + layer * 1024 + (nt < 2 ? 64 : 128);
    float4 gg[2][2];
    if (nt < 4) {
#pragma unroll
      for (int bj = 0; bj < 2; ++bj) { gg[bj][0] = *reinterpret_cast<const float4*>(g + bj * 32 + 8 * fq); gg[bj][1] = *reinterpret_cast<const float4*>(g + bj * 32 + 8 * fq + 4); }
    }
#pragma unroll
    for (int ai = 0; ai < 2; ++ai)
#pragma unroll
      for (int m = 0; m < 4; ++m) {
        const int t = u.pm * 256 + ai * 128 + wr * 64 + m * 16 + fr;
        float rstd;
        if (ui < 8) rstd = rl[ui * 256 + ai * 128 + wr * 64 + m * 16 + fr];
        else { float ss = 0.f;
#pragma unroll
          for (int j = 0; j < 16; ++j) ss += WS{P.ws}.ssq_x()[((long)batch * 16 + j) * TB + t];
          rstd = __builtin_amdgcn_rsqf(ss * (1.f / 1024.f) + EPS); }
        float v[2][8];
        float s = 0.f;
#pragma unroll
        for (int bj = 0; bj < 2; ++bj)
#pragma unroll
          for (int n = 0; n < 2; ++n)
#pragma unroll
            for (int r = 0; r < 4; ++r) { const float x = acc[ai][bj][m][n][r] * rstd; v[bj][n * 4 + r] = x; s += x * x; }
        if (nt < 4) {
          s = red4(s);
          const float inv = __builtin_amdgcn_rsqf(s * (1.f / 64.f) + EPS) * (nt < 2 ? 0.125f * LOG2E : 1.f);
          u16* dst = (nt < 2 ? WS{P.ws}.QA() : WS{P.ws}.KA()) + (long)t * 512 + (nt & 1) * 256 + wc * 64;
#pragma unroll
          for (int bj = 0; bj < 2; ++bj) {
            const int c8 = bj * 32 + 8 * fq;
            const float4 g0 = gg[bj][0], g1 = gg[bj][1];
            float y[8] = {v[bj][0] * inv * g0.x, v[bj][1] * inv * g0.y, v[bj][2] * inv * g0.z, v[bj][3] * inv * g0.w, v[bj][4] * inv * g1.x, v[bj][5] * inv * g1.y, v[bj][6] * inv * g1.z, v[bj][7] * inv * g1.w};
            store8bf(dst + c8, y);
          }
        } else if (nt < 6) {
          u16* dst = WS{P.ws}.VA() + (long)t * 512 + (nt & 1) * 256 + wc * 64;
#pragma unroll
          for (int bj = 0; bj < 2; ++bj) store8bf(dst + bj * 32 + 8 * fq, v[bj]);
        } else if (nt < 8 || nt >= 10) {
          u16* dst = WS{P.ws}.G() + (long)t * 1024 + (nt >= 10 ? 512 + (nt - 10) * 256 : (nt - 6) * 256) + wc * 64;
#pragma unroll
          for (int bj = 0; bj < 2; ++bj) {
            float y[8];
#pragma unroll
            for (int e = 0; e < 8; ++e) y[e] = siluf(v[bj][e]);
            store8bf(dst + bj * 32 + 8 * fq, y);
          }
        } else if (nt == 8) {
          u16* dst = WS{P.ws}.CQ() + (long)t * 256 + wc * 64;
#pragma unroll
          for (int bj = 0; bj < 2; ++bj) store8bf(dst + bj * 32 + 8 * fq, v[bj]);
          s = red4(s);
          if (fq == 0) WS{P.ws}.ssq_cq()[(long)wc * TB + t] = s;
        } else if (wc < 2) {
          u16* dst = WS{P.ws}.CKV() + (long)t * 128 + wc * 64;
#pragma unroll
          for (int bj = 0; bj < 2; ++bj) store8bf(dst + bj * 32 + 8 * fq, v[bj]);
          s = red4(s);
          if (fq == 0) WS{P.ws}.ssq_ckv()[(long)wc * TB + t] = s;
        } else if (wc == 2) {
          float* dst = WS{P.ws}.KR() + (long)t * 64;
#pragma unroll
          for (int bj = 0; bj < 2; ++bj) {
            *reinterpret_cast<float4*>(dst + bj * 32 + 8 * fq) = make_float4(v[bj][0], v[bj][1], v[bj][2], v[bj][3]);
            *reinterpret_cast<float4*>(dst + bj * 32 + 8 * fq + 4) = make_float4(v[bj][4], v[bj][5], v[bj][6], v[bj][7]);
          }
        }
      }
  }
};

struct PgEpiOut {
  const Params* Pp; int layer, batch;
  DEV void operator()(f32x4 (&acc)[2][2][4][2], const PgUnit& u, int ui, int wr, int wc, int fr, int fq) const {
    const Params& P = *Pp; const int nt = u.pn;
    const int n0 = nt * 256 + wc * 64 + 8 * fq;
#pragma unroll
    for (int ai = 0; ai < 2; ++ai) {
      float4 xv[4][2][2];
#pragma unroll
      for (int m = 0; m < 4; ++m) {
        const int t = u.pm * 256 + ai * 128 + wr * 64 + m * 16 + fr;
        const float* xr = layer == 0 ? (batch ? P.xin1 : P.xin0) + (long)t * DM + n0 : P.out + ((long)batch * TB + t) * DM + n0;
#pragma unroll
        for (int bj = 0; bj < 2; ++bj) { xv[m][bj][0] = *reinterpret_cast<const float4*>(xr + bj * 32); xv[m][bj][1] = *reinterpret_cast<const float4*>(xr + bj * 32 + 4); }
      }
#pragma unroll
      for (int m = 0; m < 4; ++m) {
        const int t = u.pm * 256 + ai * 128 + wr * 64 + m * 16 + fr;
        const long tg = (long)batch * TB + t;
        float s = 0.f;
#pragma unroll
        for (int bj = 0; bj < 2; ++bj) {
          const int n = n0 + bj * 32;
          const float4 x0 = xv[m][bj][0], x1 = xv[m][bj][1];
          const f32x4 a0 = acc[ai][bj][m][0], a1 = acc[ai][bj][m][1];
          float o[8] = {x0.x + a0[0], x0.y + a0[1], x0.z + a0[2], x0.w + a0[3], x1.x + a1[0], x1.y + a1[1], x1.z + a1[2], x1.w + a1[3]};
          *reinterpret_cast<float4*>(P.out + tg * DM + n) = make_float4(o[0], o[1], o[2], o[3]);
          *reinterpret_cast<float4*>(P.out + tg * DM + n + 4) = make_float4(o[4], o[5], o[6], o[7]);
          if (layer == 0) {
            store8bf(WS{P.ws}.XB() + tg * DM + n, o);
#pragma unroll
            for (int e = 0; e < 8; ++e) s += o[e] * o[e];
          }
        }
        if (layer == 0) { s = red4(s); if (fq == 0) WS{P.ws}.ssq_x()[((long)batch * 16 + nt * 4 + wc) * TB + t] = s; }
      }
    }
  }
};

template <class Epi>
DEV void pg_gemm_phase(PG_LAS unsigned char* lds, const u16* gA, const u16* gBt, int M, int N, int K, const PgOrder& S, const Epi& E) {
  const int tid = opaque_tid(), wid = __builtin_amdgcn_readfirstlane(tid >> 6), lane = tid & 63, wr = wid >> 2, wc = wid & 3, fr = lane & 15, fq = lane >> 4;
  const int nt = K / 64;
  unsigned voffA[2], voffB[2];
#pragma unroll
  for (int i = 0; i < 2; ++i) { int R, C; pg_stage_rc(tid * 16 + i * 8192, R, C);
    const int Rb = (R >> 5) * 64 + pg_perm32(R & 31);
    voffA[i] = (unsigned)(R * K + C) * 2u; voffB[i] = (unsigned)(Rb * K + C) * 2u; }
  const size_t kstep = (size_t)(64 * 2);
  const size_t hstepA = (size_t)128 * K * 2, hstepB = (size_t)32 * K * 2;
  const size_t tstep = (size_t)256 * K * 2;
  const unsigned ldsw = (unsigned)wid * 1024u;
  const int aoff = pg_lds_byte(wr * 64 + fr, fq * 8), boff = pg_lds_byte(wc * 32 + fr, fq * 8);
#define PG_SA(b, h) (((b) * 2 + (h)) * PG_HTB)
#define PG_SB(b, h) ((4 + (b) * 2 + (h)) * PG_HTB)
#define PG_STAGE(bufoff, gbase, voff) do { _Pragma("unroll") for (int _i = 0; _i < 2; ++_i) \
    __builtin_amdgcn_global_load_lds((const unsigned*)((const char*)(gbase) + (voff)[_i]), (PG_LAS unsigned*)(lds + (bufoff) + ldsw + _i * 8192), 16, 0, 0); } while (0)
#define PG_LDA(dst, b, h) do { _Pragma("unroll") for (int m = 0; m < 4; ++m) _Pragma("unroll") for (int k = 0; k < 2; ++k) dst[m][k] = *(const PG_LAS bf16x8*)(lds + PG_SA(b, h) + aoff + m * 2048 + k * 1024); } while (0)
#define PG_LDB(dst, b, h) do { _Pragma("unroll") for (int n = 0; n < 2; ++n) _Pragma("unroll") for (int k = 0; k < 2; ++k) dst[n][k] = *(const PG_LAS bf16x8*)(lds + PG_SB(b, h) + boff + n * 2048 + k * 1024); } while (0)
#define PG_MMA(ai, bj, At, Bt) do { __builtin_amdgcn_s_setprio(1); _Pragma("unroll") for (int m = 0; m < 4; ++m) _Pragma("unroll") for (int n = 0; n < 2; ++n) _Pragma("unroll") for (int k = 0; k < 2; ++k) \
    acc[ai][bj][m][n] = __builtin_amdgcn_mfma_f32_16x16x32_bf16(Bt[n][k], At[m][k], acc[ai][bj][m][n], 0, 0, 0); __builtin_amdgcn_s_setprio(0); } while (0)
#define PG_WAIT_V(n) asm volatile("s_waitcnt vmcnt(" #n ")" ::: "memory")
#define PG_WAIT_L(n) asm volatile("s_waitcnt lgkmcnt(" #n ")" ::: "memory")
#define PG_BAR __builtin_amdgcn_s_barrier()
#define PG_SCHED __builtin_amdgcn_sched_barrier(0)
  PgUnit cur, nxt; int ui = 0;
  if (!S.next(0, cur)) return;
  f32x4 acc[2][2][4][2];
#pragma unroll
  for (int a = 0; a < 2; ++a)
#pragma unroll
    for (int b = 0; b < 2; ++b)
#pragma unroll
      for (int m = 0; m < 4; ++m)
#pragma unroll
        for (int n = 0; n < 2; ++n) acc[a][b][m][n] = (f32x4){0.f, 0.f, 0.f, 0.f};
  bf16x8 At[4][2], B0[2][2], B1[2][2];
  const char* cA = (const char*)gA + (size_t)cur.pm * tstep; const char* cB = (const char*)gBt + (size_t)cur.pn * tstep;
  PG_STAGE(PG_SB(0, 0), cB, voffB); PG_STAGE(PG_SA(0, 0), cA, voffA); PG_STAGE(PG_SB(0, 1), cB + hstepB, voffB); PG_STAGE(PG_SA(0, 1), cA + hstepA, voffA);
  if (wr == 1) PG_BAR;
  PG_WAIT_V(4); PG_BAR;
  PG_STAGE(PG_SB(1, 0), cB + kstep, voffB); PG_STAGE(PG_SA(1, 0), cA + kstep, voffA); PG_STAGE(PG_SB(1, 1), cB + hstepB + kstep, voffB);
  PG_WAIT_V(6); PG_BAR;
  for (;;) {
    const bool has_next = S.next(ui + 1, nxt);
    const char* nA = has_next ? (const char*)gA + (size_t)nxt.pm * tstep : cA; const char* nB = has_next ? (const char*)gBt + (size_t)nxt.pn * tstep : cB;
    for (int t = 0; t < nt; t += 2) {
      const bool last = (t == nt - 2);
      const char* a1 = cA + (size_t)(t + 1) * kstep;
      const char* a2 = last ? nA : cA + (size_t)(t + 2) * kstep; const char* b2 = last ? nB : cB + (size_t)(t + 2) * kstep;
      const char* a3 = a2 + kstep; const char* b3 = b2 + kstep;
      PG_LDB(B0, 0, 0); PG_SCHED; PG_LDA(At, 0, 0); PG_STAGE(PG_SA(1, 1), a1 + hstepA, voffA);
      PG_WAIT_L(8); PG_BAR; PG_WAIT_L(0); PG_MMA(0, 0, At, B0); PG_BAR; PG_SCHED;
      PG_LDB(B1, 0, 1); PG_STAGE(PG_SB(0, 0), b2, voffB);
      PG_BAR; PG_WAIT_L(0); PG_MMA(0, 1, At, B1); PG_BAR;
      PG_LDA(At, 0, 1); PG_STAGE(PG_SA(0, 0), a2, voffA);
      PG_BAR; PG_WAIT_L(0); PG_MMA(1, 0, At, B0); PG_BAR; PG_SCHED;
      PG_STAGE(PG_SB(0, 1), b2 + hstepB, voffB);
      PG_WAIT_V(6); PG_BAR; PG_MMA(1, 1, At, B1); PG_BAR;
      PG_LDB(B0, 1, 0); PG_SCHED; PG_LDA(At, 1, 0); PG_STAGE(PG_SA(0, 1), a2 + hstepA, voffA);
      PG_WAIT_L(8); PG_BAR; PG_WAIT_L(0); PG_MMA(0, 0, At, B0); PG_BAR; PG_SCHED;
      PG_LDB(B1, 1, 1); PG_STAGE(PG_SB(1, 0), b3, voffB);
      PG_BAR; PG_WAIT_L(0); PG_MMA(0, 1, At, B1); PG_BAR;
      PG_LDA(At, 1, 1); PG_STAGE(PG_SA(1, 0), a3, voffA);
      PG_BAR; PG_WAIT_L(0); PG_MMA(1, 0, At, B0); PG_BAR; PG_SCHED;
      PG_STAGE(PG_SB(1, 1), b3 + hstepB, voffB);
      PG_WAIT_V(6); PG_BAR; PG_MMA(1, 1, At, B1); PG_BAR;
    }
    E(acc, cur, ui, wr, wc, fr, fq);
    if (!has_next) break;
#pragma unroll
    for (int a = 0; a < 2; ++a)
#pragma unroll
      for (int b = 0; b < 2; ++b)
#pragma unroll
        for (int m = 0; m < 4; ++m)
#pragma unroll
          for (int n = 0; n < 2; ++n) acc[a][b][m][n] = (f32x4){0.f, 0.f, 0.f, 0.f};
    cur = nxt; cA = nA; cB = nB; ++ui;
  }
  PG_WAIT_V(0);
  if (wr == 0) PG_BAR;
  PG_BAR;
#undef PG_SA
#undef PG_SB
#undef PG_STAGE
#undef PG_LDA
#undef PG_LDB
#undef PG_MMA
#undef PG_WAIT_V
#undef PG_WAIT_L
#undef PG_BAR
#undef PG_SCHED
}

#define KSWZ(row, colB) ((row) * 256 + ((colB) ^ (((row) & 7) << 4)))
DEV int v_st(int k, int c) { const int kk = (k & ~0xC) | ((k & 4) << 1) | ((k & 8) >> 1); return ((kk >> 3) * 4 + (c >> 5)) * 512 + ((kk & 7) * 32 + (c & 31)) * 2; }
DEV int v_rd_base(int lane) { return ((lane & 3) << 3) | (((lane >> 2) & 3) << 6) | (((lane >> 4) & 1) << 5) | (((lane >> 5) & 1) << 8); }
constexpr int v_rd_off(int d0, int ks, int half) { return d0 * 512 + ks * 4096 + half * 2048; }
template <int OFF> DEV s16x4 tr_read(int vb) {
  s16x4 r; asm volatile("ds_read_b64_tr_b16 %0, %1 offset:%2" : "=&v"(r) : "v"(vb), "i"(OFF) : "memory"); return r;
}
#define SGB(mask, n) __builtin_amdgcn_sched_group_barrier(mask, n, 0)
template <int D0> DEV void tr8(int vb, s16x4 (&f)[8]) {
  f[0] = tr_read<v_rd_off(D0, 0, 0)>(vb); f[1] = tr_read<v_rd_off(D0, 0, 1)>(vb); f[2] = tr_read<v_rd_off(D0, 1, 0)>(vb); f[3] = tr_read<v_rd_off(D0, 1, 1)>(vb);
  f[4] = tr_read<v_rd_off(D0, 2, 0)>(vb); f[5] = tr_read<v_rd_off(D0, 2, 1)>(vb); f[6] = tr_read<v_rd_off(D0, 3, 0)>(vb); f[7] = tr_read<v_rd_off(D0, 3, 1)>(vb);
}
DEV void mma4(f32x16& od, const s16x4 (&f)[8], bf16x8 pa0, bf16x8 pa1, bf16x8 pa2, bf16x8 pa3) {
#define PK(L, H) (bf16x8){L[0], L[1], L[2], L[3], H[0], H[1], H[2], H[3]}
  od = __builtin_amdgcn_mfma_f32_32x32x16_bf16(pa0, PK(f[0], f[1]), od, 0, 0, 0);
  od = __builtin_amdgcn_mfma_f32_32x32x16_bf16(pa1, PK(f[2], f[3]), od, 0, 0, 0);
  od = __builtin_amdgcn_mfma_f32_32x32x16_bf16(pa2, PK(f[4], f[5]), od, 0, 0, 0);
  od = __builtin_amdgcn_mfma_f32_32x32x16_bf16(pa3, PK(f[6], f[7]), od, 0, 0, 0);
#undef PK
}
DEV void pv_d0(f32x16* o, int vb, bf16x8 pa0, bf16x8 pa1, bf16x8 pa2, bf16x8 pa3) {
  s16x4 fa[8], fb[8];
  tr8<0>(vb, fa); tr8<1>(vb, fb);
  asm volatile("s_waitcnt lgkmcnt(8)" ::: "memory"); SBAR();
  mma4(o[0], fa, pa0, pa1, pa2, pa3);
  tr8<2>(vb, fa);
  asm volatile("s_waitcnt lgkmcnt(8)" ::: "memory"); SBAR();
  mma4(o[1], fb, pa0, pa1, pa2, pa3);
  tr8<3>(vb, fb);
  asm volatile("s_waitcnt lgkmcnt(8)" ::: "memory"); SBAR();
  mma4(o[2], fa, pa0, pa1, pa2, pa3);
  asm volatile("s_waitcnt lgkmcnt(0)" ::: "memory"); SBAR();
  mma4(o[3], fb, pa0, pa1, pa2, pa3);
}
DEV void softmax_pack(f32x16& p0, f32x16& p1, float& lsum, bf16x8& pa0, bf16x8& pa1, bf16x8& pa2, bf16x8& pa3) {
#pragma unroll
  for (int r = 0; r < 16; ++r) { p0[r] = __builtin_amdgcn_exp2f(p0[r]); p1[r] = __builtin_amdgcn_exp2f(p1[r]); }
  float ps = 0.f;
#pragma unroll
  for (int r = 0; r < 16; ++r) ps += p0[r] + p1[r];
  lsum += ps;
#define PK4(Pv, BASE, OUT) do { unsigned a0 = cvtpk(Pv[BASE + 0], Pv[BASE + 1]), a1 = cvtpk(Pv[BASE + 2], Pv[BASE + 3]);   \
    unsigned b0 = cvtpk(Pv[BASE + 4], Pv[BASE + 5]), b1 = cvtpk(Pv[BASE + 6], Pv[BASE + 7]);                              \
    auto r0 = __builtin_amdgcn_permlane32_swap(a0, b0, false, false); auto r1 = __builtin_amdgcn_permlane32_swap(a1, b1, false, false); \
    u32x4 w = {r0[0], r1[0], r0[1], r1[1]}; OUT = *reinterpret_cast<bf16x8*>(&w); } while (0)
  PK4(p0, 0, pa0); PK4(p0, 8, pa1); PK4(p1, 0, pa2); PK4(p1, 8, pa3);
#undef PK4
}

DEV void sm_half(f32x16& p, float& lsum, bf16x8& paLo, bf16x8& paHi) {
#pragma unroll
  for (int r = 0; r < 16; ++r) p[r] = __builtin_amdgcn_exp2f(p[r]);
  float ps = 0.f;
#pragma unroll
  for (int r = 0; r < 16; ++r) ps += p[r];
  lsum += ps;
#define PK4(Pv, BASE, OUT) do { unsigned a0 = cvtpk(Pv[BASE + 0], Pv[BASE + 1]), a1 = cvtpk(Pv[BASE + 2], Pv[BASE + 3]);   \
    unsigned b0 = cvtpk(Pv[BASE + 4], Pv[BASE + 5]), b1 = cvtpk(Pv[BASE + 6], Pv[BASE + 7]);                              \
    auto r0 = __builtin_amdgcn_permlane32_swap(a0, b0, false, false); auto r1 = __builtin_amdgcn_permlane32_swap(a1, b1, false, false); \
    u32x4 w = {r0[0], r1[0], r0[1], r1[1]}; OUT = *reinterpret_cast<bf16x8*>(&w); } while (0)
  PK4(p, 0, paLo); PK4(p, 8, paHi);
#undef PK4
}
template <int KS0, int DA> DEV void trq(int vb, s16x4 (&f)[8]) {
  f[0] = tr_read<v_rd_off(DA, KS0, 0)>(vb); f[1] = tr_read<v_rd_off(DA, KS0, 1)>(vb); f[2] = tr_read<v_rd_off(DA, KS0 + 1, 0)>(vb); f[3] = tr_read<v_rd_off(DA, KS0 + 1, 1)>(vb);
  f[4] = tr_read<v_rd_off(DA + 1, KS0, 0)>(vb); f[5] = tr_read<v_rd_off(DA + 1, KS0, 1)>(vb); f[6] = tr_read<v_rd_off(DA + 1, KS0 + 1, 0)>(vb); f[7] = tr_read<v_rd_off(DA + 1, KS0 + 1, 1)>(vb);
}
DEV void mmaq(f32x16& oa, f32x16& ob, const s16x4 (&f)[8], bf16x8 paX, bf16x8 paY) {
#define PK(L, H) (bf16x8){L[0], L[1], L[2], L[3], H[0], H[1], H[2], H[3]}
  oa = __builtin_amdgcn_mfma_f32_32x32x16_bf16(paX, PK(f[0], f[1]), oa, 0, 0, 0);
  ob = __builtin_amdgcn_mfma_f32_32x32x16_bf16(paX, PK(f[4], f[5]), ob, 0, 0, 0);
  oa = __builtin_amdgcn_mfma_f32_32x32x16_bf16(paY, PK(f[2], f[3]), oa, 0, 0, 0);
  ob = __builtin_amdgcn_mfma_f32_32x32x16_bf16(paY, PK(f[6], f[7]), ob, 0, 0, 0);
#undef PK
}
DEV void sm_exp(f32x16& p, float& lsum) {
#pragma unroll
  for (int r = 0; r < 16; ++r) p[r] = __builtin_amdgcn_exp2f(p[r]);
#pragma unroll
  for (int r = 0; r < 16; ++r) lsum += p[r];
}
DEV void sm_pack(const f32x16& p, bf16x8& paLo, bf16x8& paHi) {
  u32x4 lo = {cvtpk(p[0], p[1]), cvtpk(p[2], p[3]), cvtpk(p[4], p[5]), cvtpk(p[6], p[7])};
  u32x4 hi = {cvtpk(p[8], p[9]), cvtpk(p[10], p[11]), cvtpk(p[12], p[13]), cvtpk(p[14], p[15])};
  paLo = *reinterpret_cast<bf16x8*>(&lo); paHi = *reinterpret_cast<bf16x8*>(&hi);
}

DEV void attn_a_item(const Params& P, int layer, int batch, int item, char* lds) {
  const int tid = opaque_tid(), wid = tid >> 6, lane = tid & 63, r32 = lane & 31, hi = lane >> 5;
  const int seqlen = batch ? 16384 : 4096;
  const int head = 3 - (item >> 7), k_ = item & 127;
  const int kk_ = batch ? k_ : (k_ >> 2), mid_ = batch ? 64 : 16;
  const int qb = mid_ + ((kk_ & 1) ? -((kk_ + 1) >> 1) : (kk_ >> 1));
  const int seq = batch ? 0 : (k_ & 3);
  const long tok0 = (long)seq * 4096;
  const int c = wid >> 2, wq = wid & 3;
  const int qpos = qb * 128 + wq * 32 + r32;
  char* V_lds = lds; char* K_lds = lds + 32768;
  float* wsl = reinterpret_cast<float*>(lds + LDS_WS) + wid * 64;
  const float lam = WS{P.ws}.consts()[layer * 1024 + 0], nMC = -WS{P.ws}.consts()[layer * 1024 + 1], lam_init = WS{P.ws}.consts()[layer * 1024 + 3];
  const float nslope = -exp2f(-2.f * (float)(head + 1)) * LOG2E;
  bf16x8 qr[4];
  {
    const u16* Qw = WS{P.ws}.QA() + (tok0 + qpos) * 512 + head * 128 + c * 64 + hi * 8;
#pragma unroll
    for (int ks = 0; ks < 4; ++ks) qr[ks] = *reinterpret_cast<const bf16x8*>(Qw + ks * 16);
  }
  const u16* Kh = WS{P.ws}.KA() + tok0 * 512 + head * 128;
  const u16* Vh = WS{P.ws}.VA() + tok0 * 512 + head * 128;
  int akoff[2], avoff[2], ldst[2];
#pragma unroll
  for (int i = 0; i < 2; ++i) {
    const int p = (wid + 8 * i) * 1024 + lane * 16;
    ldst[i] = p;
    const int row = p >> 8, cB = (p & 255) ^ ((row & 7) << 4);
    akoff[i] = row * 512 + (cB >> 1);
    const int st = p >> 9, within = p & 511, kk = (st >> 2) * 8 + (within >> 6);
    const int k = kk, col = (st & 3) * 32 + ((within & 63) >> 1);
    avoff[i] = k * 512 + col;
  }
  const int vb0 = (int)(uintptr_t)V_lds + v_rd_base(lane);
#define ALOAD(b, k0) do { _Pragma("unroll") for (int i = 0; i < 2; ++i) { glds16(Kh + (long)(k0) * 512 + akoff[i], K_lds + (b) * 16384 + ldst[i]); \
    glds16(Vh + (long)(k0) * 512 + avoff[i], V_lds + (b) * 16384 + ldst[i]); } } while (0)
  f32x16 o[4] = {f32x16{}, f32x16{}, f32x16{}, f32x16{}};
  float lsum = 0.f;
  const int NT = seqlen >> 6;
  const int Dk = (int)fminf(160.f / -nslope, 1.0e6f);
  const int jlo = max(0, (qb * 128 - Dk) >> 6), jhi = min(NT - 1, (qb * 128 + 127 + Dk) >> 6);
  ALOAD(0, jlo * 64); asm volatile("s_waitcnt vmcnt(0)" ::: "memory"); __syncthreads();
  for (int j = jlo; j <= jhi; ++j) {
    const int bcur = (j - jlo) & 1;
    const char* Ks = K_lds + bcur * 16384;
    f32x16 p0, p1;
    {
      const float dbase = (float)(j * 64 - qpos + 4 * hi);
      const int q0 = qb * 128;
      if (j * 64 + 63 < q0 || j * 64 > q0 + 127) {
        const float step = (j * 64 < q0) ? -nslope : nslope;
        const float base = fmaf(dbase, step, nMC), step8 = 8.f * step;
        p0[0] = base; p0[1] = base + step; p0[2] = fmaf(2.f, step, base); p0[3] = fmaf(3.f, step, base);
#pragma unroll
        for (int r = 4; r < 16; ++r) p0[r] = p0[r - 4] + step8;
#pragma unroll
        for (int r = 0; r < 4; ++r) p1[r] = p0[r + 12] + step8;
#pragma unroll
        for (int r = 4; r < 16; ++r) p1[r] = p1[r - 4] + step8;
      } else {
        float d0[16], d1[16];
        d0[0] = dbase; d0[1] = dbase + 1.f; d0[2] = dbase + 2.f; d0[3] = d0[1] + 2.f;
#pragma unroll
        for (int r = 4; r < 16; ++r) d0[r] = d0[r - 4] + 8.f;
#pragma unroll
        for (int r = 0; r < 4; ++r) d1[r] = d0[r + 12] + 8.f;
#pragma unroll
        for (int r = 4; r < 16; ++r) d1[r] = d1[r - 4] + 8.f;
#pragma unroll
        for (int r = 0; r < 16; ++r) { p0[r] = fmaf(fabsf(d0[r]), nslope, nMC); p1[r] = fmaf(fabsf(d1[r]), nslope, nMC); }
      }
    }
    const int vb = vb0 + bcur * 16384;
    bf16x8 pa0, pa1, pa2, pa3;
    s16x4 fa[8], fb[8];
    bf16x8 kf[8];
#pragma unroll
    for (int ks = 0; ks < 4; ++ks) {
      const int cb = c * 128 + (ks * 16 + hi * 8) * 2;
      kf[2 * ks] = *reinterpret_cast<const bf16x8*>(Ks + KSWZ(r32, cb));
      kf[2 * ks + 1] = *reinterpret_cast<const bf16x8*>(Ks + KSWZ(32 + r32, cb));
    }
#pragma unroll
    for (int ks = 0; ks < 4; ++ks) p0 = __builtin_amdgcn_mfma_f32_32x32x16_bf16(kf[2 * ks], qr[ks], p0, 0, 0, 0);
    SBAR();
    if (j + 1 <= jhi) ALOAD(bcur ^ 1, (j + 1) * 64);
    SBAR();
    trq<0, 0>(vb, fa);
#pragma unroll
    for (int ks = 0; ks < 4; ++ks) p1 = __builtin_amdgcn_mfma_f32_32x32x16_bf16(kf[2 * ks + 1], qr[ks], p1, 0, 0, 0);
    sm_exp(p0, lsum); sm_pack(p0, pa0, pa1);
    asm volatile("s_waitcnt lgkmcnt(0)" ::: "memory"); SBAR();
    trq<0, 2>(vb, fb);
    mmaq(o[0], o[1], fa, pa0, pa1);
    sm_exp(p1, lsum);
    asm volatile("s_waitcnt lgkmcnt(0)" ::: "memory"); SBAR();
    trq<2, 0>(vb, fa);
    mmaq(o[2], o[3], fb, pa0, pa1);
    sm_pack(p1, pa2, pa3);
    asm volatile("s_waitcnt lgkmcnt(0)" ::: "memory"); SBAR();
    trq<2, 2>(vb, fb);
    mmaq(o[0], o[1], fa, pa2, pa3);
    asm volatile("s_waitcnt lgkmcnt(0)" ::: "memory"); SBAR();
    mmaq(o[2], o[3], fb, pa2, pa3);
    asm volatile("s_waitcnt vmcnt(0)" ::: "memory");
    __syncthreads();
  }
#undef ALOAD
  lsum = swapsum(lsum);
  if (hi == 0) wsl[r32] = (c ? lam : 1.f) / lsum;
  asm volatile("s_waitcnt lgkmcnt(0)" ::: "memory");
  float rli[16];
#pragma unroll
  for (int r = 0; r < 16; ++r) rli[r] = wsl[crow(r, hi)];
  float* Ob = reinterpret_cast<float*>(lds);
  if (c == 1) {
#pragma unroll
    for (int d0 = 0; d0 < 4; ++d0)
#pragma unroll
      for (int r = 0; r < 16; ++r) Ob[(wq * 32 + crow(r, hi)) * 132 + d0 * 32 + r32] = o[d0][r] * rli[r];
  }
  __syncthreads();
  if (c == 0) {
#pragma unroll
    for (int d0 = 0; d0 < 4; ++d0)
#pragma unroll
      for (int r = 0; r < 16; ++r) {
        float* p = &Ob[(wq * 32 + crow(r, hi)) * 132 + d0 * 32 + r32];
        *p = o[d0][r] * rli[r] - *p;
      }
  }
  __syncthreads();
  {
    const int row = tid >> 2, part = tid & 3;
    const float* src = Ob + row * 132 + part * 32;
    float v[32];
    float s = 0.f;
#pragma unroll
    for (int i = 0; i < 8; ++i) {
      const float4 x = *reinterpret_cast<const float4*>(src + i * 4);
      v[i * 4] = x.x; v[i * 4 + 1] = x.y; v[i * 4 + 2] = x.z; v[i * 4 + 3] = x.w;
      s += x.x * x.x + x.y * x.y + x.z * x.z + x.w * x.w;
    }
    s += SWZ_XOR(s, 1); s += SWZ_XOR(s, 2);
    const float inv = __builtin_amdgcn_rsqf(s * (1.f / 128.f) + EPS) * (1.f - lam_init);
    const float* sg = WS{P.ws}.consts() + layer * 1024 + 192 + part * 32;
    u16* gp = WS{P.ws}.G() + (tok0 + qb * 128 + row) * 1024 + head * 128 + part * 32;
#pragma unroll
    for (int i = 0; i < 4; ++i) {
      const u32x4 gw = *reinterpret_cast<const u32x4*>(gp + i * 8);
      float y[8];
#pragma unroll
      for (int e = 0; e < 8; ++e) {
        const unsigned w = gw[e >> 1];
        const float gate = (e & 1) ? __uint_as_float(w & 0xffff0000u) : __uint_as_float(w << 16);
        y[e] = v[i * 8 + e] * inv * sg[i * 8 + e] * gate;
      }
      store8bf(gp + i * 8, y);
    }
  }
  __syncthreads();
}

DEV void attn_b_item(const Params& P, int layer, int batch, int item, char* lds) {
  const int tid = opaque_tid(), wid = tid >> 6, lane = tid & 63, r32 = lane & 31, hi = lane >> 5;
  const int seqlen = batch ? 16384 : 4096;
  const int xcd = item & 7, jj = item >> 3;
  const int sh = batch ? (xcd >> 1) : (2 * xcd + (jj >> 4));
  const int qb = batch ? ((xcd & 1) * 32 + jj) : (jj & 15);
  const int head = sh & 3, seq = sh >> 2;
  const long tok0 = (long)seq * 4096;
  const int qpos = qb * 256 + wid * 32 + r32;
  char* V_lds = lds; char* K_lds = lds + 32768;
  float* wsl = reinterpret_cast<float*>(lds + LDS_WS) + wid * 64;
  const float nMC = -WS{P.ws}.consts()[layer * 1024 + 2];
  bf16x8 qr[12];
  {
    const u16* Qw = WS{P.ws}.QB() + (tok0 + qpos) * 768 + head * 192 + hi * 8;
#pragma unroll
    for (int ks = 0; ks < 12; ++ks) qr[ks] = *reinterpret_cast<const bf16x8*>(Qw + ks * 16);
  }
  const u16* Kh = WS{P.ws}.KB() + tok0 * 768 + head * 192;
  const u16* Vh = WS{P.ws}.VB() + tok0 * 512 + head * 128;
  int bkoff[3], bvoff[2], ldst[3];
#pragma unroll
  for (int i = 0; i < 3; ++i) {
    const int p = (wid + 8 * i) * 1024 + lane * 16;
    ldst[i] = p;
    const int row = p / 384, pch = (p - row * 384) >> 4, ch = pch ^ ((row >> 1) & 7);
    bkoff[i] = row * 768 + ch * 8;
    if (i < 2) {
      const int st = p >> 9, within = p & 511, kk = (st >> 2) * 8 + (within >> 6);
      const int k = kk, col = (st & 3) * 32 + ((within & 63) >> 1);
      bvoff[i] = k * 512 + col;
    }
  }
  const int vb0 = (int)(uintptr_t)V_lds + v_rd_base(lane);
  const int kq = r32 * 384, ksw = (r32 >> 1) & 7;
#define BLOAD(b, k0) do { _Pragma("unroll") for (int i = 0; i < 3; ++i) glds16(Kh + (long)(k0) * 768 + bkoff[i], K_lds + (b) * 24576 + ldst[i]); \
    _Pragma("unroll") for (int i = 0; i < 2; ++i) glds16(Vh + (long)(k0) * 512 + bvoff[i], V_lds + (b) * 16384 + ldst[i]); } while (0)
  f32x16 o[4] = {f32x16{}, f32x16{}, f32x16{}, f32x16{}};
  float lsum = 0.f;
  const int NT = seqlen >> 6;
  BLOAD(0, 0); asm volatile("s_waitcnt vmcnt(0)" ::: "memory"); __syncthreads();
  for (int j = 0; j < NT; ++j) {
    const char* Ks = K_lds + (j & 1) * 24576;
    const int vb = vb0 + (j & 1) * 16384;
    f32x16 p0, p1;
#pragma unroll
    for (int r = 0; r < 16; ++r) { p0[r] = 0.f; p1[r] = 0.f; }
    bf16x8 pa0, pa1, pa2, pa3;
    s16x4 fa[8], fb[8];
    {
      bf16x8 kf[12];
#pragma unroll
      for (int ks = 0; ks < 12; ++ks) kf[ks] = *reinterpret_cast<const bf16x8*>(Ks + kq + (((ks * 2 + hi) ^ ksw) << 4));
#pragma unroll
      for (int ks = 0; ks < 12; ++ks) p0 = __builtin_amdgcn_mfma_f32_32x32x16_bf16(kf[ks], qr[ks], p0, 0, 0, 0);
      SGB(0x100, 4); SGB(0x008, 2); SGB(0x100, 2); SGB(0x008, 2); SGB(0x100, 2); SGB(0x008, 2); SGB(0x100, 2); SGB(0x008, 2); SGB(0x100, 2); SGB(0x008, 4);
    }
    SBAR();
    if (j + 1 < NT) BLOAD((j + 1) & 1, (j + 1) * 64);
    SBAR();
    {
      trq<0, 0>(vb, fa);
      bf16x8 kf[12];
#pragma unroll
      for (int ks = 0; ks < 12; ++ks) kf[ks] = *reinterpret_cast<const bf16x8*>(Ks + kq + 32 * 384 + (((ks * 2 + hi) ^ ksw) << 4));
#pragma unroll
      for (int ks = 0; ks < 12; ++ks) p1 = __builtin_amdgcn_mfma_f32_32x32x16_bf16(kf[ks], qr[ks], p1, 0, 0, 0);
      sm_exp(p0, lsum); sm_pack(p0, pa0, pa1);
    }
    asm volatile("s_waitcnt lgkmcnt(0)" ::: "memory"); SBAR();
    trq<0, 2>(vb, fb);
    mmaq(o[0], o[1], fa, pa0, pa1);
    sm_exp(p1, lsum);
    asm volatile("s_waitcnt lgkmcnt(0)" ::: "memory"); SBAR();
    trq<2, 0>(vb, fa);
    mmaq(o[2], o[3], fb, pa0, pa1);
    sm_pack(p1, pa2, pa3);
    asm volatile("s_waitcnt lgkmcnt(0)" ::: "memory"); SBAR();
    trq<2, 2>(vb, fb);
    mmaq(o[0], o[1], fa, pa2, pa3);
    asm volatile("s_waitcnt lgkmcnt(0)" ::: "memory"); SBAR();
    mmaq(o[2], o[3], fb, pa2, pa3);
    asm volatile("s_waitcnt vmcnt(0)" ::: "memory");
    __syncthreads();
  }
#undef BLOAD
  lsum = swapsum(lsum);
  if (hi == 0) wsl[r32] = 1.f / lsum;
  asm volatile("s_waitcnt lgkmcnt(0)" ::: "memory");
  u16* gp = WS{P.ws}.G() + (tok0 + qb * 256 + wid * 32) * 1024 + 512 + head * 128 + r32;
#pragma unroll
  for (int r = 0; r < 16; ++r) {
    const int row = crow(r, hi);
    const float rl = wsl[row];
#pragma unroll
    for (int d0 = 0; d0 < 4; ++d0) {
      u16* p = gp + (long)row * 1024 + d0 * 32;
      const float y = o[d0][r] * rl * bf2f(*p);
      *p = (u16)(cvtpk(y, 0.f) & 0xffffu);
    }
  }
  __syncthreads();
}

DEV void phase_inproj(const Params& P, int layer, int batch, char* lds) {
  PgOrder S; S.init(TB, NPAD, opaque_nb(), opaque_bid());
  PG_LAS float* rl = (PG_LAS float*)(lds + 131072);
  {
    const int tid = opaque_tid();
#pragma unroll 1
    for (int i0 = 0; i0 < 8; i0 += 2) {
      const int i = i0 + (tid >> 8); PgUnit u;
      if (S.next(i, u)) {
        const int t = u.pm * 256 + (tid & 255);
        float ss = 0.f;
#pragma unroll
        for (int j = 0; j < 16; ++j) ss += WS{P.ws}.ssq_x()[((long)batch * 16 + j) * TB + t];
        rl[i * 256 + (tid & 255)] = __builtin_amdgcn_rsqf(ss * (1.f / 1024.f) + EPS);
      }
    }
    __syncthreads();
  }
  PgEpiIn E{&P, layer, batch, rl};
  pg_gemm_phase((PG_LAS unsigned char*)lds, WS{P.ws}.XB() + (long)batch * TB * DM, WS{P.ws}.WinT() + (long)layer * NPAD * DM, TB, NPAD, 1024, S, E);
}
DEV void phase_up(const Params& P, int layer, int batch, char* lds) {
  for (int tile = opaque_bid(), nb_ = opaque_nb(); tile < 512; tile += nb_) {
    const int kind = tile >> 8, rem = tile & 255, head = rem & 3, mt = rem >> 2;
    if (kind == 0) gemm_tile<8, 1, 256, EPI_UKV>(WS{P.ws}.CKV(), 128, WS{P.ws}.WukvT() + ((long)layer * 1024 + head * 256) * 128, 128, 128, mt * 256, lds, P, layer, batch, head);
    else           gemm_tile<8, 1, 192, EPI_UQ>(WS{P.ws}.CQ(), 256, WS{P.ws}.WuqT() + ((long)layer * 768 + head * 192) * 256, 256, 256, mt * 256, lds, P, layer, batch, head);
  }
}
DEV void phase_attn(const Params& P, int layer, int batch, char* lds) {
  unsigned* ctr = reinterpret_cast<unsigned*>(P.ws + O_CONST + 8192 - 512) + (batch * 2 + layer) * 16;
  volatile int* qw = reinterpret_cast<volatile int*>(lds + LDS_WS + 2048 - 16);
  for (;;) {
    if (threadIdx.x == 0) *qw = (int)__hip_atomic_fetch_add(ctr, 1u, __ATOMIC_RELAXED, __HIP_MEMORY_SCOPE_AGENT);
    __syncthreads();
    const int it = __builtin_amdgcn_readfirstlane(*qw);
    __syncthreads();
    if (it >= 768) break;
    if (it < 256) attn_b_item(P, layer, batch, it, lds);
    else          attn_a_item(P, layer, batch, it - 256, lds);
  }
}
DEV void phase_outproj(const Params& P, int layer, int batch, char* lds) {
  PgOrder S; S.init(TB, 1024, opaque_nb(), opaque_bid());
  PgEpiOut E{&P, layer, batch};
  pg_gemm_phase((PG_LAS unsigned char*)lds, WS{P.ws}.G(), WS{P.ws}.WoutT() + (long)layer * 1024 * DM, TB, 1024, 1024, S, E);
}

DEV void grid_bar(unsigned* ctr, unsigned target) {
  asm volatile("s_waitcnt vmcnt(0)" ::: "memory");
  __syncthreads();
  if (threadIdx.x == 0) {
    __builtin_amdgcn_fence(__ATOMIC_RELEASE, "agent");
    asm volatile("s_waitcnt vmcnt(0)" ::: "memory");
    __hip_atomic_fetch_add(ctr, 1u, __ATOMIC_RELAXED, __HIP_MEMORY_SCOPE_AGENT);
    while (__hip_atomic_load(ctr, __ATOMIC_RELAXED, __HIP_MEMORY_SCOPE_AGENT) < target) __builtin_amdgcn_s_sleep(1);
    __builtin_amdgcn_fence(__ATOMIC_ACQUIRE, "agent");
    asm volatile("s_waitcnt vmcnt(0)" ::: "memory");
  }
  __syncthreads();
}

__global__ __launch_bounds__(NTHR, 1) void hymba_mega(Params P) {
  extern __shared__ __attribute__((aligned(16))) char lds[];
  cg::grid_group grid = cg::this_grid();
  unsigned* bctr = reinterpret_cast<unsigned*>(P.ws + O_CONST + 8192 - 256);
  if (blockIdx.x == 0 && threadIdx.x == 0) *bctr = 0u;
  if (blockIdx.x == 0 && threadIdx.x < 64) reinterpret_cast<unsigned*>(P.ws + O_CONST + 8192 - 512)[threadIdx.x] = 0u;
  phase_prologue(P, lds);
  grid.sync();
  unsigned nbar = 0;
  for (int batch = 0; batch < 2; ++batch) {
    for (int layer = 0; layer < 2; ++layer) {
      Params Q = P;
#define LAUNDER() do { char* w_ = P.ws; float* o_ = P.out; asm volatile("" : "+s"(w_), "+s"(o_)); Q.ws = w_; Q.out = o_; } while (0)
#define GBAR() do { ++nbar; grid_bar(reinterpret_cast<unsigned*>(Q.ws + O_CONST + 8192 - 256), nbar * gridDim.x); } while (0)
      LAUNDER(); phase_inproj(Q, layer, batch, lds);
      GBAR();
      LAUNDER(); phase_up(Q, layer, batch, lds);
      GBAR();
      LAUNDER(); phase_attn(Q, layer, batch, lds);
      GBAR();
      LAUNDER(); phase_outproj(Q, layer, batch, lds);
      if (!(batch == 1 && layer == 1)) GBAR();
#undef LAUNDER
#undef GBAR
    }
  }
}

extern "C" void kernel_launch(void* const* d_in, const int* in_sizes, int n_in, void* d_out, int out_size, void* d_ws, size_t ws_size, hipStream_t stream) {
  static int grid_blocks = 0;
  if (grid_blocks == 0) {
    int dev = 0, cus = 0, per_cu = 0;
    (void)hipGetDevice(&dev);
    (void)hipDeviceGetAttribute(&cus, hipDeviceAttributeMultiprocessorCount, dev);
    if (hipFuncSetAttribute((const void*)hymba_mega, hipFuncAttributeMaxDynamicSharedMemorySize, LDS_BYTES) != hipSuccess) { fprintf(stderr, "hipFuncSetAttribute failed\n"); grid_blocks = -1; return; }
    if (hipOccupancyMaxActiveBlocksPerMultiprocessor(&per_cu, (const void*)hymba_mega, NTHR, LDS_BYTES) != hipSuccess || per_cu < 1) { fprintf(stderr, "occupancy query: %d\n", per_cu); per_cu = 1; }
    (void)hipGetLastError();
    grid_blocks = cus * per_cu;
  }
  if (grid_blocks < 0) return;
  Params p{};
  p.xin0 = (const float*)d_in[0]; p.xin1 = (const float*)d_in[1];
  p.norm_w = (const float*)d_in[2]; p.w_in = (const float*)d_in[3]; p.a_q_norm = (const float*)d_in[4]; p.a_k_norm = (const float*)d_in[5];
  p.a_lq1 = (const float*)d_in[6]; p.a_lk1 = (const float*)d_in[7]; p.a_lq2 = (const float*)d_in[8]; p.a_lk2 = (const float*)d_in[9];
  p.a_subln = (const float*)d_in[10]; p.b_cq_norm = (const float*)d_in[11]; p.b_w_uq = (const float*)d_in[12]; p.b_ckv_norm = (const float*)d_in[13];
  p.b_w_ukv = (const float*)d_in[14]; p.b_q_norm = (const float*)d_in[15]; p.b_k_norm = (const float*)d_in[16]; p.w_out = (const float*)d_in[17];
  p.out = (float*)d_out;
  p.ws = (char*)d_ws;
  if (WS_END > ws_size) { fprintf(stderr, "workspace too small: need %zu have %zu\n", (size_t)WS_END, ws_size); return; }
  void* args[] = {&p};
  hipError_t e = hipLaunchCooperativeKernel((const void*)hymba_mega, dim3(grid_blocks), dim3(NTHR), args, LDS_BYTES, stream);
  if (e != hipSuccess) fprintf(stderr, "cooperative launch failed: %s (grid %d)\n", hipGetErrorString(e), grid_blocks);
}
```
